# Optimizing an MI355X kernel written in HIP

```python
import math
import jax, jax.numpy as jnp
from jax import lax
import numpy as np

D_MODEL = 2048
BATCH = 2
SEQ = 4096
DEPTH = 1
DEC_BATCH = 8
DEC_SEQ = 4
PAST_LEN = 16384
PAGE_SIZE = 128

N_HEADS = 16
HEAD_DIM = 64
ATTN_WIDTH = N_HEADS * HEAD_DIM
POOL_WINDOWS = (2, 4, 8, 16)
POOL_GROUPS = len(POOL_WINDOWS)
POOL_WIDTH = D_MODEL // 2
POOL_GROUP_CH = POOL_WIDTH // POOL_GROUPS
POOL_OUT_CH = D_MODEL // POOL_GROUPS
POOL_STATE = max(POOL_WINDOWS) - 1
D_FF = ((8 * D_MODEL // 3 + 255) // 256) * 256
IN_COLS = 3 * ATTN_WIDTH + POOL_WIDTH + 2 * D_MODEL
Q_BLOCK = 128
RMS_EPS = 1e-6
SB_BIAS_HI = -5.0
SB_BIAS_LO = -10.0

kernel_name = "stickbreak_pool_gated_hybrid_step"


def rms_norm(x, g):
    xf = x.astype(jnp.float32)
    xf = xf * lax.rsqrt(jnp.mean(xf * xf, axis=-1, keepdims=True) + RMS_EPS)
    return xf.astype(x.dtype) * g


def in_proj(x, norm_g, w_in, q_g, k_g):
    b, t = x.shape[:2]
    h = rms_norm(x, norm_g) @ w_in
    cuts = [ATTN_WIDTH, 2 * ATTN_WIDTH, 3 * ATTN_WIDTH, 3 * ATTN_WIDTH + POOL_WIDTH,
            3 * ATTN_WIDTH + POOL_WIDTH + D_MODEL]
    q, k, v, u, g_attn, g_pool = jnp.split(h, cuts, axis=-1)
    q = rms_norm(q.reshape(b, t, N_HEADS, HEAD_DIM), q_g)
    k = rms_norm(k.reshape(b, t, N_HEADS, HEAD_DIM), k_g)
    v = v.reshape(b, t, N_HEADS, HEAD_DIM)
    return q, k, v, u, g_attn, g_pool


def stick_breaking(q, k, v, sb_bias, q_pos, k_pos):
    z = jnp.einsum('bthd,bshd->bhts', q.astype(jnp.float32), k.astype(jnp.float32)) * (HEAD_DIM ** -0.5)
    z = z + sb_bias.astype(jnp.float32)[None, :, None, None]
    causal = k_pos[None, :] < q_pos[:, None]
    log_keep = jnp.where(causal, jax.nn.log_sigmoid(-z), 0.0)
    after = lax.cumsum(log_keep, axis=3, reverse=True) - log_keep
    log_a = jnp.where(causal, jax.nn.log_sigmoid(z) + after, -jnp.inf)
    a = jnp.exp(log_a).astype(v.dtype)
    return jnp.einsum('bhts,bshd->bthd', a, v)


def stick_breaking_blocked(q, k, v, sb_bias):
    b, s = q.shape[:2]
    nb = s // Q_BLOCK
    pos = jnp.arange(s, dtype=jnp.int32)
    q_blocks = q.reshape(b, nb, Q_BLOCK, N_HEADS, HEAD_DIM).swapaxes(0, 1)
    p_blocks = pos.reshape(nb, Q_BLOCK)
    out = lax.map(lambda qp: stick_breaking(qp[0], k, v, sb_bias, qp[1], pos), (q_blocks, p_blocks))
    return out.swapaxes(0, 1).reshape(b, s, N_HEADS, HEAD_DIM)


def pool_branch(u_ext, pos, w_pool, pool_scale):
    b = u_ext.shape[0]
    t = pos.shape[0]
    uf = u_ext.astype(jnp.float32)
    cs = jnp.concatenate([jnp.zeros((b, 1, POOL_WIDTH), jnp.float32), jnp.cumsum(uf, axis=1)], axis=1)
    u_new = uf[:, POOL_STATE:]
    groups = []
    for g, w in enumerate(POOL_WINDOWS):
        lo, hi = g * POOL_GROUP_CH, (g + 1) * POOL_GROUP_CH
        win_sum = cs[:, POOL_STATE + 1:, lo:hi] - cs[:, POOL_STATE + 1 - w:POOL_STATE + 1 - w + t, lo:hi]
        cnt = jnp.minimum(w, pos + 1).astype(jnp.float32)[None, :, None]
        groups.append(win_sum / cnt - u_new[..., lo:hi])
    p = jnp.stack(groups, axis=2).astype(u_ext.dtype)
    out = jnp.einsum('btgc,gce->btge', p, w_pool).reshape(b, t, D_MODEL)
    return out * pool_scale


def merge_and_ffn(x, o_attn, o_pool, g_attn, g_pool, w_attn_proj, w_out, norm2_g, w_gate_up, w_down):
    b, t = x.shape[:2]
    a = o_attn.reshape(b, t, ATTN_WIDTH) @ w_attn_proj
    mixed = jax.nn.sigmoid(g_attn) * a + jax.nn.sigmoid(g_pool) * o_pool
    h = x + mixed @ w_out
    gate, up = jnp.split(rms_norm(h, norm2_g) @ w_gate_up, 2, axis=-1)
    return h + (jax.nn.silu(gate) * up) @ w_down


def setup_inputs(seed: int = 0) -> dict:
    key = jax.random.key(seed)
    ks = jax.random.split(key, 20)
    n_pages = PAST_LEN // PAGE_SIZE
    n_used = DEC_BATCH * n_pages
    n_pool = n_used + (n_used + 3) // 4
    f32 = jnp.float32

    def nrm(k, shape, scale=1.0):
        return jax.random.normal(k, shape, f32) * scale

    page_table = jax.random.permutation(ks[5], n_pool)[:n_used].reshape(DEC_BATCH, n_pages).astype(jnp.int32)
    sb_bias = jnp.broadcast_to(jnp.linspace(SB_BIAS_HI, SB_BIAS_LO, N_HEADS, dtype=f32), (DEPTH, N_HEADS)) \
        + nrm(ks[17], (DEPTH, N_HEADS), 0.1)
    return {
        "x_prompt": nrm(ks[0], (BATCH, SEQ, D_MODEL)),
        "x_sample": nrm(ks[1], (DEC_BATCH, DEC_SEQ, D_MODEL)),
        "cache_k": nrm(ks[2], (DEPTH, n_pool, PAGE_SIZE, N_HEADS, HEAD_DIM)),
        "cache_v": nrm(ks[3], (DEPTH, n_pool, PAGE_SIZE, N_HEADS, HEAD_DIM)),
        "state_pool": nrm(ks[4], (DEPTH, DEC_BATCH, POOL_STATE, POOL_WIDTH)),
        "page_table": page_table,
        "norm1_g": 1.0 + nrm(ks[6], (DEPTH, D_MODEL), 0.1),
        "w_in": nrm(ks[7], (DEPTH, D_MODEL, IN_COLS), D_MODEL ** -0.5),
        "q_norm_g": 1.0 + nrm(ks[8], (DEPTH, HEAD_DIM), 0.1),
        "k_norm_g": 1.0 + nrm(ks[9], (DEPTH, HEAD_DIM), 0.1),
        "sb_bias": sb_bias,
        "w_attn_proj": nrm(ks[10], (DEPTH, ATTN_WIDTH, D_MODEL), ATTN_WIDTH ** -0.5),
        "w_pool": nrm(ks[11], (DEPTH, POOL_GROUPS, POOL_GROUP_CH, POOL_OUT_CH), POOL_GROUP_CH ** -0.5),
        "pool_scale": 1.0 + nrm(ks[12], (DEPTH, D_MODEL), 0.1),
        "w_out": nrm(ks[13], (DEPTH, D_MODEL, D_MODEL), D_MODEL ** -0.5),
        "norm2_g": 1.0 + nrm(ks[14], (DEPTH, D_MODEL), 0.1),
        "w_gate_up": nrm(ks[15], (DEPTH, D_MODEL, 2 * D_FF), D_MODEL ** -0.5),
        "w_down": nrm(ks[16], (DEPTH, D_FF, D_MODEL), D_FF ** -0.5),
    }


def reference(x_prompt, x_sample, cache_k, cache_v, state_pool, page_table, norm1_g, w_in,
              q_norm_g, k_norm_g, sb_bias, w_attn_proj, w_pool, pool_scale, w_out, norm2_g, w_gate_up, w_down):
    b_p, seq = x_prompt.shape[:2]
    b_s, t_s = x_sample.shape[:2]
    n_pages = page_table.shape[1]
    past_len = n_pages * cache_k.shape[2]
    pos_p = jnp.arange(seq, dtype=jnp.int32)
    pos_s = past_len + jnp.arange(t_s, dtype=jnp.int32)
    k_pos_s = jnp.arange(past_len + t_s, dtype=jnp.int32)

    xp, xs = x_prompt, x_sample
    kp_l, vp_l, up_l, ks_l, vs_l, us_l = [], [], [], [], [], []
    for l in range(DEPTH):
        q, k, v, u, ga, gb = in_proj(xp, norm1_g[l], w_in[l], q_norm_g[l], k_norm_g[l])
        o_attn = stick_breaking_blocked(q, k, v, sb_bias[l])
        u_ext = jnp.concatenate([jnp.zeros((b_p, POOL_STATE, POOL_WIDTH), u.dtype), u], axis=1)
        o_pool = pool_branch(u_ext, pos_p, w_pool[l], pool_scale[l])
        kp_l.append(k)
        vp_l.append(v)
        up_l.append(u_ext[:, -POOL_STATE:])
        xp = merge_and_ffn(xp, o_attn, o_pool, ga, gb, w_attn_proj[l], w_out[l], norm2_g[l],
                           w_gate_up[l], w_down[l])

        q, k, v, u, ga, gb = in_proj(xs, norm1_g[l], w_in[l], q_norm_g[l], k_norm_g[l])
        k_past = cache_k[l][page_table].reshape(b_s, past_len, N_HEADS, HEAD_DIM)
        v_past = cache_v[l][page_table].reshape(b_s, past_len, N_HEADS, HEAD_DIM)
        k_all = jnp.concatenate([k_past, k], axis=1)
        v_all = jnp.concatenate([v_past, v], axis=1)
        o_attn = stick_breaking(q, k_all, v_all, sb_bias[l], pos_s, k_pos_s)
        u_ext = jnp.concatenate([state_pool[l], u], axis=1)
        o_pool = pool_branch(u_ext, pos_s, w_pool[l], pool_scale[l])
        ks_l.append(k)
        vs_l.append(v)
        us_l.append(u_ext[:, -POOL_STATE:])
        xs = merge_and_ffn(xs, o_attn, o_pool, ga, gb, w_attn_proj[l], w_out[l], norm2_g[l],
                           w_gate_up[l], w_down[l])

    k_prompt_new = jnp.stack(kp_l, axis=0)
    v_prompt_new = jnp.stack(vp_l, axis=0)
    pool_prompt_new = jnp.stack(up_l, axis=0)
    k_sample_new = jnp.stack(ks_l, axis=0)
    v_sample_new = jnp.stack(vs_l, axis=0)
    pool_sample_new = jnp.stack(us_l, axis=0)
    return (xp, xs, k_prompt_new, v_prompt_new, pool_prompt_new, k_sample_new, v_sample_new, pool_sample_new)
```

```cpp
#include <hip/hip_runtime.h>
#include <cstdio>
#include <cstdint>

#define LAS __attribute__((address_space(3)))
#define GAS __attribute__((address_space(1)))
typedef unsigned short bf16_t;
typedef short bf16x8 __attribute__((ext_vector_type(8)));
typedef short s16x4 __attribute__((ext_vector_type(4)));
typedef float f32x2 __attribute__((ext_vector_type(2)));
typedef float f32x4 __attribute__((ext_vector_type(4)));
typedef float f32x16 __attribute__((ext_vector_type(16)));
typedef unsigned u32x2 __attribute__((ext_vector_type(2)));
typedef unsigned u32x4 __attribute__((ext_vector_type(4)));
typedef __bf16 bf16x2_t __attribute__((ext_vector_type(2)));

#ifndef MK_N_LAUNCHES
#define MK_N_LAUNCHES 1
#endif

constexpr int DM = 2048, NB = 2, SEQ = 4096, MP = NB * SEQ, DB = 8, DS = 4, MS = DB * DS, MR = MP + MS, MPAD = 8448;
constexpr int NH = 16, HD = 64, AW = 1024, PW = 1024, DFF = 5632, INC = 8192;
constexpr int PAST = 16384, PAGE = 128, NPG = PAST / PAGE, PSTATE = 15;
constexpr int DCH = 32;
constexpr float LOG2E = 1.4426950408889634f, C2 = 0.125f * LOG2E, EPS = 1e-6f;
constexpr size_t OFF_YP = 0, OFF_YS = (size_t)MP * DM, OFF_KP = OFF_YS + (size_t)MS * DM, OFF_VP = OFF_KP + (size_t)MP * AW, OFF_PP = OFF_VP + (size_t)MP * AW,
                 OFF_KS = OFF_PP + (size_t)NB * PSTATE * PW, OFF_VS = OFF_KS + (size_t)MS * AW, OFF_PS = OFF_VS + (size_t)MS * AW, OUT_TOTAL = OFF_PS + (size_t)DB * PSTATE * PW;

__device__ __forceinline__ unsigned cvtpk(float lo, float hi) { f32x2 v = {lo, hi}; bf16x2_t b = __builtin_convertvector(v, bf16x2_t); return __builtin_bit_cast(unsigned, b); }
__device__ __forceinline__ float bflo(unsigned u) { return __uint_as_float(u << 16); }
__device__ __forceinline__ float bfhi(unsigned u) { return __uint_as_float(u & 0xffff0000u); }
__device__ __forceinline__ u32x4 pack8(const f32x4 a, const f32x4 b) { u32x4 w; w.x = cvtpk(a[0], a[1]); w.y = cvtpk(a[2], a[3]); w.z = cvtpk(b[0], b[1]); w.w = cvtpk(b[2], b[3]); return w; }
__device__ __forceinline__ void unpack8(const u32x4 w, f32x4& a, f32x4& b) { a = (f32x4){bflo(w.x), bfhi(w.x), bflo(w.y), bfhi(w.y)}; b = (f32x4){bflo(w.z), bfhi(w.z), bflo(w.w), bfhi(w.w)}; }
__device__ __forceinline__ float sigm(float x) { return 1.0f / (1.0f + __expf(-x)); }

namespace pg8 {
constexpr int BM = 256, BK = 64, HALF = 128, HTB = HALF * BK * 2  , STAGE_BYTES = 8 * HTB, NXCD = 8, WGM = 8;
__host__ __device__ __forceinline__ int lds_byte(int r, int c) { const int st = (r >> 4) * 2 + (c >> 5), rr = r & 15, cc = c & 31, ob = rr * 64 + cc * 2; return st * 1024 + (ob ^ (((ob >> 9) & 1) << 5)); }
__host__ __device__ __forceinline__ void stage_rc(int b, int& R, int& C) { const int st = b / 1024, sb = b % 1024, swz = sb ^ (((sb >> 9) & 1) << 5); R = (st >> 1) * 16 + swz / 64; C = (st & 1) * 32 + (swz % 64) / 2; }
__host__ __device__ __forceinline__ int perm32(int rho) { const int n = rho >> 4, i = rho & 15; return 8 * (i >> 2) + 4 * n + (i & 3); }

struct Unit { int pm, pn; };
struct Gemm { const bf16_t* A; const bf16_t* Bt; int lda, ldb, K, agrp_shift, agrp_stride; };

struct StaticOrder {
    int nM, nN, nwg, G, c;
    __host__ __device__ void init(int M, int N, int G_, int c_) { nM = M / BM; nN = N / BM; nwg = nM * nN; G = G_; c = c_; }
    __host__ __device__ bool next(int i, Unit& u) const {
        const long L = (long)i * G + c; if (L >= nwg) return false;
        int wgid = (int)L; { const int q = nwg / NXCD, r = nwg % NXCD, xcd = wgid % NXCD, off = wgid / NXCD; wgid = (xcd < r ? xcd * (q + 1) : r * (q + 1) + (xcd - r) * q) + off; }
        const int nig = WGM * nN, gid = wgid / nig, fm = gid * WGM, gsz = (nM - fm) < WGM ? (nM - fm) : WGM;
        u.pm = fm + ((wgid % nig) % gsz); u.pn = (wgid % nig) / gsz; return true;
    }
    __device__ __forceinline__ void a_ready(const Unit&) const {}
    __device__ __forceinline__ void done(const Unit&) const {}
};

template <class Epi, class Sched>
__device__ __forceinline__ void gemm_phase(LAS unsigned char* lds, const Gemm g, const Sched& S, const Epi& E) {
    const int tid = threadIdx.x, wid = __builtin_amdgcn_readfirstlane(tid >> 6), lane = tid & 63, wr = wid >> 2, wc = wid & 3, fr = lane & 15, fq = lane >> 4;
    int nt = g.K / BK; asm volatile("" : "+s"(nt));
    unsigned voffA[2], voffB[2];
#pragma unroll
    for (int i = 0; i < 2; ++i) { int R, C; stage_rc(tid * 16 + i * 8192, R, C); const int Rb = Epi::PERM ? ((R & ~31) + perm32(R & 31)) : R;
        voffA[i] = (unsigned)(R * g.lda + C) * 2u; voffB[i] = (unsigned)(Rb * g.ldb + C) * 2u; }
    const size_t kstep = (size_t)(BK * 2);
    const size_t hstepA = (size_t)HALF * g.lda * 2, hstepB = (size_t)HALF * g.ldb * 2;
    const size_t tstepA = 2 * hstepA, tstepB = 2 * hstepB;
    const unsigned ldsw = (unsigned)wid * 1024u;
    const int aoff = lds_byte(wr * 64 + fr, fq * 8), boff = lds_byte(wc * 32 + fr, fq * 8);
#define PG8_SA(b, h) (((b) * 2 + (h)) * HTB)
#define PG8_SB(b, h) ((4 + (b) * 2 + (h)) * HTB)
#define PG8_STAGE(bufoff, gbase, voff) do { _Pragma("unroll") for (int _i = 0; _i < 2; ++_i) \
        __builtin_amdgcn_global_load_lds((const unsigned*)((const char*)(gbase) + (voff)[_i]), (LAS unsigned*)(lds + (bufoff) + ldsw + _i * 8192), 16, 0, 0); } while (0)
#define PG8_LDA(dst, b, h) do { _Pragma("unroll") for (int m = 0; m < 4; ++m) _Pragma("unroll") for (int k = 0; k < 2; ++k) dst[m][k] = *(const LAS bf16x8*)(lds + PG8_SA(b, h) + aoff + m * 2048 + k * 1024); } while (0)
#define PG8_LDB(dst, b, h) do { _Pragma("unroll") for (int n = 0; n < 2; ++n) _Pragma("unroll") for (int k = 0; k < 2; ++k) dst[n][k] = *(const LAS bf16x8*)(lds + PG8_SB(b, h) + boff + n * 2048 + k * 1024); } while (0)
#define PG8_MMA(ai, bj, At, Bt) do { __builtin_amdgcn_s_setprio(1); _Pragma("unroll") for (int m = 0; m < 4; ++m) _Pragma("unroll") for (int n = 0; n < 2; ++n) _Pragma("unroll") for (int k = 0; k < 2; ++k) \
        acc[ai][bj][m][n] = __builtin_amdgcn_mfma_f32_16x16x32_bf16(Bt[n][k], At[m][k], acc[ai][bj][m][n], 0, 0, 0); __builtin_amdgcn_s_setprio(0); } while (0)
#define PG8_WAIT_V(n) asm volatile("s_waitcnt vmcnt(" #n ")" ::: "memory")
#define PG8_WAIT_L(n) asm volatile("s_waitcnt lgkmcnt(" #n ")" ::: "memory")
#define PG8_BAR __builtin_amdgcn_s_barrier()
#define PG8_SCHED __builtin_amdgcn_sched_barrier(0)
#define PG8_ABASE(u) ((const char*)g.A + (size_t)(u).pm * tstepA + (size_t)(((u).pn >> g.agrp_shift) * g.agrp_stride) * 2)
    Unit cur, nxt; int ui = 0;
    if (!S.next(0, cur)) return;
    f32x4 acc[2][2][4][2];
#pragma unroll
    for (int a = 0; a < 2; ++a)
#pragma unroll
        for (int b = 0; b < 2; ++b)
#pragma unroll
            for (int m = 0; m < 4; ++m)
#pragma unroll
                for (int n = 0; n < 2; ++n) acc[a][b][m][n] = (f32x4){0.f, 0.f, 0.f, 0.f};
    bf16x8 At[4][2], B0[2][2], B1[2][2];
    const char* cA = PG8_ABASE(cur); const char* cB = (const char*)g.Bt + (size_t)cur.pn * tstepB;
    S.a_ready(cur);
    PG8_STAGE(PG8_SB(0, 0), cB, voffB); PG8_STAGE(PG8_SB(0, 1), cB + hstepB, voffB); PG8_STAGE(PG8_SA(0, 0), cA, voffA); PG8_STAGE(PG8_SA(0, 1), cA + hstepA, voffA);
    if (wr == 1) PG8_BAR;
    PG8_WAIT_V(2); PG8_BAR;
    PG8_STAGE(PG8_SB(1, 0), cB + kstep, voffB); PG8_STAGE(PG8_SA(1, 0), cA + kstep, voffA); PG8_STAGE(PG8_SB(1, 1), cB + hstepB + kstep, voffB);
    PG8_WAIT_V(6); PG8_BAR;
    for (;;) {
        const bool has_next = S.next(ui + 1, nxt);
        const char* nA = has_next ? PG8_ABASE(nxt) : cA; const char* nB = has_next ? (const char*)g.Bt + (size_t)nxt.pn * tstepB : cB;
        for (int t = 0; t < nt; t += 2) {
            const bool last = (t == nt - 2);
            const char* a1 = cA + (size_t)(t + 1) * kstep;
            const char* a2 = last ? nA : cA + (size_t)(t + 2) * kstep; const char* b2 = last ? nB : cB + (size_t)(t + 2) * kstep;
            const char* a3 = a2 + kstep; const char* b3 = b2 + kstep;
            if (last && has_next) S.a_ready(nxt);
            PG8_LDB(B0, 0, 0); PG8_LDB(B1, 0, 1); PG8_SCHED; PG8_LDA(At, 0, 0); PG8_STAGE(PG8_SA(1, 1), a1 + hstepA, voffA);
            PG8_WAIT_V(8); PG8_WAIT_L(0); PG8_BAR; PG8_MMA(0, 0, At, B0); PG8_MMA(0, 1, At, B1); PG8_BAR; PG8_SCHED;
            PG8_LDA(At, 0, 1); PG8_STAGE(PG8_SB(0, 0), b2, voffB); PG8_STAGE(PG8_SB(0, 1), b2 + hstepB, voffB); PG8_STAGE(PG8_SA(0, 0), a2, voffA);
            PG8_WAIT_V(8); PG8_WAIT_L(0); PG8_BAR; PG8_MMA(1, 0, At, B0); PG8_MMA(1, 1, At, B1); PG8_BAR; PG8_SCHED;
            PG8_LDB(B0, 1, 0); PG8_LDB(B1, 1, 1); PG8_SCHED; PG8_LDA(At, 1, 0); PG8_STAGE(PG8_SA(0, 1), a2 + hstepA, voffA);
            PG8_WAIT_V(8); PG8_WAIT_L(0); PG8_BAR; PG8_MMA(0, 0, At, B0); PG8_MMA(0, 1, At, B1); PG8_BAR; PG8_SCHED;
            PG8_LDA(At, 1, 1); PG8_STAGE(PG8_SB(1, 0), b3, voffB); PG8_STAGE(PG8_SB(1, 1), b3 + hstepB, voffB); PG8_STAGE(PG8_SA(1, 0), a3, voffA);
            PG8_WAIT_V(8); PG8_WAIT_L(0); PG8_BAR; PG8_MMA(1, 0, At, B0); PG8_MMA(1, 1, At, B1); PG8_BAR; PG8_SCHED;
        }
        if (wr == 0) PG8_BAR;
        E(acc, cur, wr, wc, fr, fq); S.done(cur);
        if (!has_next) break;
#pragma unroll
        for (int a = 0; a < 2; ++a)
#pragma unroll
            for (int b = 0; b < 2; ++b)
#pragma unroll
                for (int m = 0; m < 4; ++m)
#pragma unroll
                    for (int n = 0; n < 2; ++n) acc[a][b][m][n] = (f32x4){0.f, 0.f, 0.f, 0.f};
        cur = nxt; cA = nA; cB = nB; ++ui;
        if (wr == 1) PG8_BAR;
    }
    PG8_WAIT_V(0);
    PG8_BAR;
#undef PG8_SA
#undef PG8_SB
#undef PG8_STAGE
#undef PG8_LDA
#undef PG8_LDB
#undef PG8_MMA
#undef PG8_WAIT_V
#undef PG8_WAIT_L
#undef PG8_BAR
#undef PG8_SCHED
#undef PG8_ABASE
}

#define EPI_ROWS_BEGIN _Pragma("unroll") for (int ai = 0; ai < 2; ++ai) _Pragma("unroll") for (int m = 0; m < 4; ++m) { \
        const int row0 = u.pm * BM + ai * HALF + wr * 64 + m * 16; if (row0 < MR) { const int row = row0 + fr;
#define EPI_ROWS_END } }

struct EpiIn {
    static constexpr bool PERM = true;
    bf16_t *Q, *Kb, *Vb, *SGA, *SGB; float* U; float* out; const float *qg, *kg;
    __device__ __forceinline__ void operator()(const f32x4 (&acc)[2][2][4][2], const Unit& u, int wr, int wc, int fr, int fq) const {
        const int kind = u.pn >> 2;
        EPI_ROWS_BEGIN
            if (kind <= 1) {
                float ss = 0.f;
#pragma unroll
                for (int bj = 0; bj < 2; ++bj)
#pragma unroll
                    for (int n = 0; n < 2; ++n) { const f32x4 x = acc[ai][bj][m][n]; ss += (x[0] * x[0] + x[1] * x[1]) + (x[2] * x[2] + x[3] * x[3]); }
                ss += __shfl_xor(ss, 16); ss += __shfl_xor(ss, 32);
                const float sc = rsqrtf(ss * (1.0f / 64.0f) + EPS) * (kind == 0 ? C2 : 1.0f);
                const float* g = kind == 0 ? qg : kg;
                const int head = (u.pn & 3) * 4 + wc;
                float* kn = row0 < MP ? out + OFF_KP + (size_t)row * AW : out + OFF_KS + (size_t)(row - MP) * AW;
#pragma unroll
                for (int bj = 0; bj < 2; ++bj) {
                    const int d0 = 32 * bj + 8 * fq, col = head * 64 + d0;
                    const f32x4 g0 = *(const f32x4*)(g + d0), g1 = *(const f32x4*)(g + d0 + 4);
                    const f32x4 v0 = acc[ai][bj][m][0] * sc * g0, v1 = acc[ai][bj][m][1] * sc * g1;
                    if (kind == 0) { *(u32x4*)(Q + (size_t)row * AW + col) = pack8(v0, v1); }
                    else { *(f32x4*)(kn + col) = v0; *(f32x4*)(kn + col + 4) = v1; *(u32x4*)(Kb + (size_t)row * AW + col) = pack8(v0, v1); }
                }
            } else if (kind == 2) {
                float* vn = row0 < MP ? out + OFF_VP + (size_t)row * AW : out + OFF_VS + (size_t)(row - MP) * AW;
#pragma unroll
                for (int bj = 0; bj < 2; ++bj) {
                    const int col = (u.pn - 8) * 256 + 64 * wc + 32 * bj + 8 * fq;
                    const f32x4 v0 = acc[ai][bj][m][0], v1 = acc[ai][bj][m][1];
                    *(f32x4*)(vn + col) = v0; *(f32x4*)(vn + col + 4) = v1; *(u32x4*)(Vb + (size_t)row * AW + col) = pack8(v0, v1);
                }
            } else if (kind == 3) {
#pragma unroll
                for (int bj = 0; bj < 2; ++bj) {
                    const int col = (u.pn - 12) * 256 + 64 * wc + 32 * bj + 8 * fq;
                    *(f32x4*)(U + (size_t)row * PW + col) = acc[ai][bj][m][0]; *(f32x4*)(U + (size_t)row * PW + col + 4) = acc[ai][bj][m][1];
                }
            } else {
                bf16_t* S = kind < 6 ? SGA : SGB;
                const int cb = (kind < 6 ? u.pn - 16 : u.pn - 24) * 256;
#pragma unroll
                for (int bj = 0; bj < 2; ++bj) {
                    const int col = cb + 64 * wc + 32 * bj + 8 * fq;
                    f32x4 v0 = acc[ai][bj][m][0], v1 = acc[ai][bj][m][1];
#pragma unroll
                    for (int e = 0; e < 4; ++e) { v0[e] = sigm(v0[e]); v1[e] = sigm(v1[e]); }
                    *(u32x4*)(S + (size_t)row * DM + col) = pack8(v0, v1);
                }
            }
        EPI_ROWS_END
    }
};
struct EpiPool {
    static constexpr bool PERM = true;
    const bf16_t* SGB; const float* ps; bf16_t* MIX;
    __device__ __forceinline__ void operator()(const f32x4 (&acc)[2][2][4][2], const Unit& u, int wr, int wc, int fr, int fq) const {
        EPI_ROWS_BEGIN
#pragma unroll
            for (int bj = 0; bj < 2; ++bj) {
                const int col = u.pn * BM + bj * HALF + wc * 32 + 8 * fq;
                f32x4 s0, s1; unpack8(*(const u32x4*)(SGB + (size_t)row * DM + col), s0, s1);
                const f32x4 p0 = *(const f32x4*)(ps + col), p1 = *(const f32x4*)(ps + col + 4);
                *(u32x4*)(MIX + (size_t)row * DM + col) = pack8(acc[ai][bj][m][0] * p0 * s0, acc[ai][bj][m][1] * p1 * s1);
            }
        EPI_ROWS_END
    }
};
struct EpiProj {
    static constexpr bool PERM = true;
    const bf16_t* SGA; bf16_t* MIX;
    __device__ __forceinline__ void operator()(const f32x4 (&acc)[2][2][4][2], const Unit& u, int wr, int wc, int fr, int fq) const {
        EPI_ROWS_BEGIN
#pragma unroll
            for (int bj = 0; bj < 2; ++bj) {
                const int col = u.pn * BM + bj * HALF + wc * 32 + 8 * fq;
                f32x4 s0, s1, q0, q1; unpack8(*(const u32x4*)(SGA + (size_t)row * DM + col), s0, s1); unpack8(*(const u32x4*)(MIX + (size_t)row * DM + col), q0, q1);
                *(u32x4*)(MIX + (size_t)row * DM + col) = pack8(acc[ai][bj][m][0] * s0 + q0, acc[ai][bj][m][1] * s1 + q1);
            }
        EPI_ROWS_END
    }
};
struct EpiOut {
    static constexpr bool PERM = true;
    const float *xp, *xs; float* H; bf16_t* HB; float* SS;
    __device__ __forceinline__ void operator()(const f32x4 (&acc)[2][2][4][2], const Unit& u, int wr, int wc, int fr, int fq) const {
        EPI_ROWS_BEGIN
            const float* xr = row0 < MP ? xp + (size_t)row * DM : xs + (size_t)(row - MP) * DM;
            float ss = 0.f;
#pragma unroll
            for (int bj = 0; bj < 2; ++bj) {
                const int col = u.pn * BM + bj * HALF + wc * 32 + 8 * fq;
                const f32x4 h0 = *(const f32x4*)(xr + col) + acc[ai][bj][m][0], h1 = *(const f32x4*)(xr + col + 4) + acc[ai][bj][m][1];
                *(f32x4*)(H + (size_t)row * DM + col) = h0; *(f32x4*)(H + (size_t)row * DM + col + 4) = h1;
                *(u32x4*)(HB + (size_t)row * DM + col) = pack8(h0, h1);
                ss += (h0[0] * h0[0] + h0[1] * h0[1]) + (h0[2] * h0[2] + h0[3] * h0[3]) + (h1[0] * h1[0] + h1[1] * h1[1]) + (h1[2] * h1[2] + h1[3] * h1[3]);
            }
            ss += __shfl_xor(ss, 16); ss += __shfl_xor(ss, 32);
            if (fq == 0) SS[(size_t)row * 32 + u.pn * 4 + wc] = ss;
        EPI_ROWS_END
    }
};
struct EpiGU {
    static constexpr bool PERM = true;
    const float* SS; bf16_t* ACT;
    __device__ __forceinline__ void operator()(const f32x4 (&acc)[2][2][4][2], const Unit& u, int wr, int wc, int fr, int fq) const {
        EPI_ROWS_BEGIN
            const f32x4* sp = (const f32x4*)(SS + (size_t)row * 32);
            f32x4 t = sp[0];
#pragma unroll
            for (int j = 1; j < 8; ++j) t += sp[j];
            const float rstd = rsqrtf(((t[0] + t[1]) + (t[2] + t[3])) * (1.0f / DM) + EPS);
            const int col = u.pn * HALF + wc * 32 + 8 * fq;
            f32x4 a0, a1;
#pragma unroll
            for (int e = 0; e < 4; ++e) { const float g0 = acc[ai][0][m][0][e] * rstd, g1 = acc[ai][0][m][1][e] * rstd;
                a0[e] = g0 * sigm(g0) * (acc[ai][1][m][0][e] * rstd); a1[e] = g1 * sigm(g1) * (acc[ai][1][m][1][e] * rstd); }
            *(u32x4*)(ACT + (size_t)row * DFF + col) = pack8(a0, a1);
        EPI_ROWS_END
    }
};
struct EpiDown {
    static constexpr bool PERM = true;
    float* H;
    __device__ __forceinline__ void operator()(const f32x4 (&acc)[2][2][4][2], const Unit& u, int wr, int wc, int fr, int fq) const {
        EPI_ROWS_BEGIN
#pragma unroll
            for (int bj = 0; bj < 2; ++bj) {
                float* hp = H + (size_t)row * DM + u.pn * BM + bj * HALF + wc * 32 + 8 * fq;
                const f32x4 y0 = *(const f32x4*)hp + acc[ai][bj][m][0], y1 = *(const f32x4*)(hp + 4) + acc[ai][bj][m][1];
                *(f32x4*)hp = y0; *(f32x4*)(hp + 4) = y1;
            }
        EPI_ROWS_END
    }
};
}

namespace att {
typedef short v4i16_t __attribute__((ext_vector_type(4)));
typedef LAS const char* lds_cptr;
constexpr int LDS_K = 0, LDS_V = 16384, LDS_OST = 32768, LDS_BYTES = 65536;
__device__ __forceinline__ s16x4 vtr(lds_cptr p) { return __builtin_bit_cast(s16x4, __builtin_amdgcn_ds_read_tr16_b64_v4i16((LAS v4i16_t*)p)); }

template <int MODE>
__device__ __forceinline__ void sb_tile(f32x16 (&o)[2], float& carry, const bf16x8 (&qr)[4], lds_cptr kp, lds_cptr vp, float bias2, int qrel, int hi) {
    f32x16 p0, p1;
#pragma unroll
    for (int r = 0; r < 16; ++r) { p0[r] = bias2; p1[r] = bias2; }
#pragma unroll
    for (int d0 = 0; d0 < 4; ++d0) {
        const bf16x8 b0 = *(const LAS bf16x8*)(kp + d0 * 2048), b1 = *(const LAS bf16x8*)(kp + d0 * 2048 + 512);
        p0 = __builtin_amdgcn_mfma_f32_32x32x16_bf16(b0, qr[d0], p0, 0, 0, 0);
        p1 = __builtin_amdgcn_mfma_f32_32x32x16_bf16(b1, qr[d0], p1, 0, 0, 0);
    }
    if (MODE == 1) {
#pragma unroll
        for (int r = 0; r < 16; ++r) { const int kv = (r & 3) + 8 * (r >> 2) + 4 * hi; if (kv >= qrel) p0[r] = -INFINITY; if (kv + 32 >= qrel) p1[r] = -INFINITY; }
    }
    float e[32], s[32], G[8];
#pragma unroll
    for (int r = 0; r < 16; ++r) { e[r] = __builtin_amdgcn_exp2f(p0[r]); e[16 + r] = __builtin_amdgcn_exp2f(p1[r]); }
#pragma unroll
    for (int r = 0; r < 32; ++r) s[r] = __builtin_amdgcn_rcpf(1.0f + e[r]);
#pragma unroll
    for (int gi = 0; gi < 8; ++gi) { s[4 * gi + 2] *= s[4 * gi + 3]; s[4 * gi + 1] *= s[4 * gi + 2]; s[4 * gi] *= s[4 * gi + 1]; G[gi] = s[4 * gi]; }
    float S = carry;
#pragma unroll
    for (int gi = 7; gi >= 0; --gi) {
        const auto rr = __builtin_amdgcn_permlane32_swap(__float_as_uint(G[gi]), __float_as_uint(G[gi]), false, false);
        const float Glo = __uint_as_float(rr[0]), Ghi = __uint_as_float(rr[1]);
        const float E = hi ? S : S * Ghi;
#pragma unroll
        for (int j = 0; j < 4; ++j) e[4 * gi + j] = e[4 * gi + j] * s[4 * gi + j] * E;
        S = S * (Glo * Ghi);
    }
    carry = S;
    bf16x8 pa[4];
#pragma unroll
    for (int ks = 0; ks < 4; ++ks) { u32x4 w; w.x = cvtpk(e[8 * ks], e[8 * ks + 1]); w.y = cvtpk(e[8 * ks + 2], e[8 * ks + 3]); w.z = cvtpk(e[8 * ks + 4], e[8 * ks + 5]); w.w = cvtpk(e[8 * ks + 6], e[8 * ks + 7]);
        pa[ks] = __builtin_bit_cast(bf16x8, w); }
#pragma unroll
    for (int dh = 0; dh < 2; ++dh)
#pragma unroll
        for (int ks = 0; ks < 4; ++ks) {
            const s16x4 lo = vtr(vp + dh * 4096 + ks * 1024), hi4 = vtr(vp + dh * 4096 + ks * 1024 + 512);
            const bf16x8 vf = (bf16x8){lo[0], lo[1], lo[2], lo[3], hi4[0], hi4[1], hi4[2], hi4[3]};
            o[dh] = __builtin_amdgcn_mfma_f32_32x32x16_bf16(pa[ks], vf, o[dh], 0, 0, 0);
        }
}

__device__ __forceinline__ void prompt_unit(int b, int h, int qb, const bf16_t* Q, const bf16_t* K, const bf16_t* V, bf16_t* O, const float* sbb, LAS unsigned char* lds) {
    const int tid = threadIdx.x, lane = tid & 63, r32 = lane & 31, hi = lane >> 5; const int wid = __builtin_amdgcn_readfirstlane(tid >> 6);
    const size_t rowbase = (size_t)b * SEQ; const int q0 = qb * 256;
    const bf16_t* Qw = Q + (rowbase + q0 + wid * 32) * AW + h * HD;
    const bf16_t* Kh = K + rowbase * AW + h * HD; const bf16_t* Vh = V + rowbase * AW + h * HD;
    const bf16_t* ksrc = Kh + (size_t)lane * AW + wid * 8;
    const bf16_t* vsrc = Vh + (size_t)(16 * (wid & 3) + (lane >> 2)) * AW + (wid >> 2) * 32 + (lane & 3) * 8;
    const lds_cptr l3 = (lds_cptr)lds;
    const lds_cptr kp0 = l3 + LDS_K + hi * 1024 + r32 * 16;
    const lds_cptr vp0 = l3 + LDS_V + ((lane >> 4) & 1) * 32 + (lane & 3) * 8 + (4 * hi + ((lane & 15) >> 2)) * 64;
#define ATT_DMA(t, slot) do { \
        __builtin_amdgcn_global_load_lds((const unsigned*)(ksrc + (size_t)(t) * 64 * AW), (LAS unsigned*)(lds + LDS_K + (slot) * 8192 + wid * 1024), 16, 0, 0); \
        __builtin_amdgcn_global_load_lds((const unsigned*)(vsrc + (size_t)(t) * 64 * AW), (LAS unsigned*)(lds + LDS_V + (slot) * 8192 + wid * 1024), 16, 0, 0); } while (0)
    const int NT = (q0 + 256) / 64;
    ATT_DMA(NT - 1, 0);
    bf16x8 qr[4];
#pragma unroll
    for (int d0 = 0; d0 < 4; ++d0) qr[d0] = *(const bf16x8*)(Qw + (size_t)r32 * AW + d0 * 16 + hi * 8);
    const float bias2 = sbb[h] * LOG2E;
    f32x16 o[2]; o[0] = f32x16{}; o[1] = f32x16{};
    float carry = 1.0f;
    asm volatile("s_waitcnt vmcnt(0)" ::: "memory"); __builtin_amdgcn_s_barrier();
    int slot = 0;
    for (int t = NT - 1; t >= 0; --t) {
        if (t > 0) ATT_DMA(t - 1, slot ^ 1);
        const int qmin = q0 + wid * 32 - 64 * t;
        if (qmin + 31 > 0) {
            if (qmin >= 64) sb_tile<0>(o, carry, qr, kp0 + slot * 8192, vp0 + slot * 8192, bias2, 0, hi);
            else sb_tile<1>(o, carry, qr, kp0 + slot * 8192, vp0 + slot * 8192, bias2, qmin + r32, hi);
        }
        asm volatile("s_waitcnt vmcnt(0) lgkmcnt(0)" ::: "memory"); __builtin_amdgcn_s_barrier();
        slot ^= 1;
    }
#undef ATT_DMA
    LAS bf16_t* stg = (LAS bf16_t*)(lds + LDS_OST) + wid * 2048;
#pragma unroll
    for (int r = 0; r < 16; ++r) { const int orow = (r & 3) + 8 * (r >> 2) + 4 * hi;
#pragma unroll
        for (int dh = 0; dh < 2; ++dh) stg[orow * 64 + dh * 32 + r32] = (bf16_t)(cvtpk(o[dh][r], 0.f) & 0xffffu); }
    asm volatile("s_waitcnt lgkmcnt(0)" ::: "memory");
    bf16_t* Ow = O + (rowbase + q0 + wid * 32) * AW + h * HD;
#pragma unroll
    for (int i = 0; i < 4; ++i) { const int row = i * 8 + (lane >> 3), ch = lane & 7; const u32x4 v = *(const LAS u32x4*)(stg + row * 64 + ch * 8); *(u32x4*)(Ow + (size_t)row * AW + ch * 8) = v; }
    asm volatile("s_waitcnt lgkmcnt(0)" ::: "memory"); __builtin_amdgcn_s_barrier();
}

__device__ __forceinline__ void decode_unit(int b, int c, const bf16_t* Q, const float* ck, const float* cv, const int* pt, const float* sbb, float* DPO, float* DPW, LAS unsigned char* lds) {
    const int tid = threadIdx.x, lane = tid & 63, r32 = lane & 31, hi = lane >> 5; const int wid = __builtin_amdgcn_readfirstlane(tid >> 6);
    LAS unsigned char* wl = lds + wid * 16384;
    const lds_cptr kp0 = (lds_cptr)wl + hi * 1024 + r32 * 16;
    const lds_cptr vp0 = (lds_cptr)wl + 8192 + ((lane >> 4) & 1) * 32 + (lane & 3) * 8 + (4 * hi + ((lane & 15) >> 2)) * 64;
    const int tk = lane >> 4, d4 = (lane & 15) * 4;
    LAS unsigned char* kw = wl + (d4 >> 3) * 1024 + (d4 & 7) * 2;
    LAS unsigned char* vw = wl + 8192 + (d4 >> 5) * 4096 + (d4 & 31) * 2;
    for (int hh = 0; hh < 2; ++hh) {
        const int h = 2 * wid + hh;
        bf16x8 qr[4];
#pragma unroll
        for (int d0 = 0; d0 < 4; ++d0) { qr[d0] = (bf16x8){0, 0, 0, 0, 0, 0, 0, 0}; if (r32 < DS) qr[d0] = *(const bf16x8*)(Q + (size_t)(MP + b * DS + r32) * AW + h * HD + d0 * 16 + hi * 8); }
        const float bias2 = sbb[h] * LOG2E;
        f32x16 o[2]; o[0] = f32x16{}; o[1] = f32x16{};
        float carry = 1.0f;
        for (int tt = 7; tt >= 0; --tt) {
            const int page = pt[b * NPG + c * 4 + (tt >> 1)];
            const size_t tok0 = (size_t)page * PAGE + (tt & 1) * 64;
            const float* kb = ck + ((tok0 + tk) * NH + h) * HD + d4;
            const float* vb = cv + ((tok0 + tk) * NH + h) * HD + d4;
            f32x4 kr[16];
#pragma unroll
            for (int i = 0; i < 16; ++i) kr[i] = *(const f32x4*)(kb + (size_t)i * 4 * NH * HD);
#pragma unroll
            for (int i = 0; i < 16; ++i) { u32x2 w; w.x = cvtpk(kr[i][0], kr[i][1]); w.y = cvtpk(kr[i][2], kr[i][3]); *(LAS u32x2*)(kw + (4 * i + tk) * 16) = w; }
#pragma unroll
            for (int i = 0; i < 16; ++i) kr[i] = *(const f32x4*)(vb + (size_t)i * 4 * NH * HD);
#pragma unroll
            for (int i = 0; i < 16; ++i) { u32x2 w; w.x = cvtpk(kr[i][0], kr[i][1]); w.y = cvtpk(kr[i][2], kr[i][3]); *(LAS u32x2*)(vw + (4 * i + tk) * 64) = w; }
            asm volatile("s_waitcnt lgkmcnt(0)" ::: "memory");
            sb_tile<0>(o, carry, qr, kp0, vp0, bias2, 0, hi);
            asm volatile("s_waitcnt lgkmcnt(0)" ::: "memory");
        }
        if (hi == 0) {
            float* op = DPO + ((((size_t)b * NH + h) * DCH + c) * DS) * HD;
#pragma unroll
            for (int q = 0; q < DS; ++q)
#pragma unroll
                for (int dh = 0; dh < 2; ++dh) op[q * HD + dh * 32 + r32] = o[dh][q];
            if (r32 < DS) DPW[(((size_t)b * NH + h) * DCH + c) * DS + r32] = carry;
        }
    }
}
}

constexpr int NWAVES = 8;
constexpr int N_PHASES = 8;
constexpr size_t MiB = 1u << 20;
constexpr size_t WS_CTL = 0, CTL_ZERO_BYTES = 1 * MiB;
constexpr size_t WS_WIN = 2 * MiB, WS_WAP = 34 * MiB, WS_WPOOL = 38 * MiB, WS_WOUT = 40 * MiB, WS_WGU = 48 * MiB, WS_WD = 92 * MiB;
constexpr size_t WS_XN = 114 * MiB, WS_Q = 148 * MiB, WS_K = 165 * MiB, WS_V = 182 * MiB, WS_U = 199 * MiB, WS_SGA = 232 * MiB, WS_SGB = 265 * MiB;
constexpr size_t WS_P = 298 * MiB, WS_O = 315 * MiB, WS_MIX = 332 * MiB, WS_HB = 365 * MiB, WS_SS = 398 * MiB, WS_ACT = 400 * MiB, WS_DPO = 491 * MiB, WS_DPW = 495 * MiB, WS_END = 496 * MiB;
static_assert(WS_WIN + (size_t)INC * DM * 2 <= WS_WAP && WS_WAP + (size_t)DM * AW * 2 <= WS_WPOOL && WS_WPOOL + (size_t)DM * 256 * 2 <= WS_WOUT && WS_WOUT + (size_t)DM * DM * 2 <= WS_WGU &&
              WS_WGU + (size_t)2 * DFF * DM * 2 <= WS_WD && WS_WD + (size_t)DM * DFF * 2 <= WS_XN && WS_XN + (size_t)MPAD * DM * 2 <= WS_Q && WS_Q + (size_t)MPAD * AW * 2 <= WS_K &&
              WS_K + (size_t)MPAD * AW * 2 <= WS_V && WS_V + (size_t)MPAD * AW * 2 <= WS_U && WS_U + (size_t)MPAD * PW * 4 <= WS_SGA && WS_SGA + (size_t)MPAD * DM * 2 <= WS_SGB &&
              WS_SGB + (size_t)MPAD * DM * 2 <= WS_P && WS_P + (size_t)MPAD * PW * 2 <= WS_O && WS_O + (size_t)MPAD * AW * 2 <= WS_MIX && WS_MIX + (size_t)MPAD * DM * 2 <= WS_HB &&
              WS_HB + (size_t)MPAD * DM * 2 <= WS_SS && WS_SS + (size_t)MPAD * 32 * 4 <= WS_ACT && WS_ACT + (size_t)MPAD * DFF * 2 <= WS_DPO &&
              WS_DPO + (size_t)DB * NH * DCH * DS * HD * 4 <= WS_DPW && WS_DPW + (size_t)DB * NH * DCH * DS * 4 <= WS_END, "d_ws map");
constexpr int CW_TMO = 0, CW_BAR = 4096;
constexpr int RING_OFF = 0, RING_BYTES = 131072;
constexpr int LDSCTL_OFF = RING_BYTES, MISC_OFF = LDSCTL_OFF + 320;
constexpr int LDS_BYTES = 147456;

typedef GAS unsigned gu32;
#define RLX_AGENT __ATOMIC_RELAXED, __HIP_MEMORY_SCOPE_AGENT
#define LDS_WAIT() asm volatile("s_waitcnt lgkmcnt(0)" ::: "memory")

#define XB_TMO      128
#define XB_XCNT(j)  (256  + 64 * (j))
#define XB_XSUB(j)  (1280 + 64 * (j))
#define XB_XGEN(j)  (2304 + 64 * (j))
#define XB_TOP      3328
#define XB_TOPGEN   3392
#define XCD_BAR_WORDS 3456
#define XB_SPIN_CAP (1u << 18)
__device__ __forceinline__ unsigned xb_ld(unsigned* p)              { return __hip_atomic_load(p, __ATOMIC_RELAXED, __HIP_MEMORY_SCOPE_AGENT); }
__device__ __forceinline__ unsigned xb_add(unsigned* p, unsigned v) { return __hip_atomic_fetch_add(p, v, __ATOMIC_RELAXED, __HIP_MEMORY_SCOPE_AGENT); }
__device__ __forceinline__ unsigned xb_xcc_id() { return (unsigned)__builtin_amdgcn_s_getreg((3 << 11) | 20) & 0xFu; }
#define XB_SPIN(cond, bar) do { unsigned _sp = 0; while (cond) { __builtin_amdgcn_s_sleep(1); \
    if ((++_sp & 255u) == 0u) { if (xb_ld(&(bar)[XB_TMO])) break; if (_sp > XB_SPIN_CAP) { atomicAdd(&(bar)[XB_TMO], 1u); break; } } } } while (0)
struct XcdBarrier { unsigned* bar; unsigned x; volatile LAS unsigned* st; };
__device__ __forceinline__ XcdBarrier xcd_barrier_post(unsigned* bar, volatile LAS unsigned* st) {
    XcdBarrier b; b.bar = bar; b.x = xb_xcc_id(); b.st = st;
    if (threadIdx.x == 0) (void)xb_add(&bar[XB_XCNT(b.x)], 1u);
    return b;
}
__device__ __forceinline__ void xcd_barrier_complete(unsigned* bar, unsigned x, unsigned& nloc, unsigned& nx) {
    const unsigned G = gridDim.x * gridDim.y * gridDim.z;
    unsigned sum, cnt, mine, sp = 0u;
    for (;;) {
        sum = 0u; cnt = 0u; mine = 0u;
#pragma unroll
        for (unsigned j = 0; j < 16; ++j) { const unsigned c = xb_ld(&bar[XB_XCNT(j)]); sum += c; cnt += (c > 0u) ? 1u : 0u; mine = (j == x) ? c : mine; }
        if (sum == G) break;
        __builtin_amdgcn_s_sleep(1);
        if ((++sp & 255u) == 0u) { if (xb_ld(&bar[XB_TMO])) break; if (sp > XB_SPIN_CAP) { atomicAdd(&bar[XB_TMO], 1u); break; } }
    }
    nloc = mine > 0u ? mine : 1u; nx = cnt > 0u ? cnt : 1u;
}
__device__ __forceinline__ void xcd_barrier(const XcdBarrier& b) {
    asm volatile("s_waitcnt vmcnt(0)" ::: "memory");
    __syncthreads();
    if (threadIdx.x == 0) {
        unsigned* bar = b.bar;
        __builtin_amdgcn_s_waitcnt(0);
        unsigned nloc = b.st[0], nx = b.st[1];
        if (nloc == 0u) { xcd_barrier_complete(bar, b.x, nloc, nx); b.st[0] = nloc; b.st[1] = nx; }
        const unsigned old = xb_add(&bar[XB_XSUB(b.x)], 1u);
        const unsigned gen = old / nloc;
        if (old + 1u == (gen + 1u) * nloc) {
            __builtin_amdgcn_fence(__ATOMIC_RELEASE, "agent");
            asm volatile("s_waitcnt vmcnt(0)" ::: "memory");
            const unsigned og = xb_add(&bar[XB_TOP], 1u);
            const unsigned tg = og / nx;
            if (og + 1u == (tg + 1u) * nx) xb_add(&bar[XB_TOPGEN], 1u);
            else XB_SPIN(xb_ld(&bar[XB_TOPGEN]) == tg, bar);
            __builtin_amdgcn_fence(__ATOMIC_ACQUIRE, "agent");
            xb_add(&bar[XB_XGEN(b.x)], 1u);
            asm volatile("s_waitcnt vmcnt(0)" ::: "memory");
        } else {
            XB_SPIN(xb_ld(&bar[XB_XGEN(b.x)]) == gen, bar);
            __builtin_amdgcn_fence(__ATOMIC_ACQUIRE, "agent");
            asm volatile("s_waitcnt vmcnt(0)" ::: "memory");
        }
    }
    __syncthreads();
}

__device__ __forceinline__ float wave_sum(float v) {
#pragma unroll
    for (int o = 1; o < 64; o <<= 1) v += __shfl_xor(v, o);
    return v;
}

__device__ __forceinline__ void p0_transpose_item(const float* src, int ldn, bf16_t* dst, int ldk, const float* ksc, LAS float* scr, int lane) {
#pragma unroll 8
    for (int i = 0; i < 32; ++i) { const int kk = 2 * i + (lane >> 5); float v = src[(size_t)kk * ldn + (lane & 31)]; if (ksc) v *= ksc[kk]; scr[kk * 33 + (lane & 31)] = v; }
    LDS_WAIT(); asm volatile("" ::: "memory");
    const int c = lane & 7;
#pragma unroll
    for (int j = 0; j < 4; ++j) { const int n = (lane >> 3) + 8 * j; const LAS float* s = scr + (8 * c) * 33 + n;
        u32x4 o; o.x = cvtpk(s[0 * 33], s[1 * 33]); o.y = cvtpk(s[2 * 33], s[3 * 33]); o.z = cvtpk(s[4 * 33], s[5 * 33]); o.w = cvtpk(s[6 * 33], s[7 * 33]);
        *(u32x4*)(dst + (size_t)n * ldk + 8 * c) = o; }
    LDS_WAIT(); asm volatile("" ::: "memory");
}

struct Args { const void* in[18]; float* out; unsigned char* ws; int ph_lo, ph_hi, li, pad; };

__global__ void __launch_bounds__(NWAVES * 64, 2) fwd_kernel(Args args) {
    extern __shared__ __attribute__((aligned(16))) unsigned char lds_raw[];
    LAS unsigned char* lds = (LAS unsigned char*)lds_raw;
    volatile LAS unsigned* MISC = (volatile LAS unsigned*)(lds + MISC_OFF);
    const int tid = threadIdx.x, lane = tid & 63, wave = __builtin_amdgcn_readfirstlane(tid >> 6);
    const int G = gridDim.x; const int bx = blockIdx.x; const int vcu = (G % 8 == 0) ? (bx % 8) * (G / 8) + bx / 8 : bx;
    const int gw = vcu * NWAVES + wave, NGW = G * NWAVES;
    unsigned char* ws = args.ws;
    unsigned* ctl = (unsigned*)(ws + WS_CTL);
    const float* x_p = (const float*)args.in[0]; const float* x_s = (const float*)args.in[1];
    const float* cache_k = (const float*)args.in[2]; const float* cache_v = (const float*)args.in[3];
    const float* state_pool = (const float*)args.in[4]; const int* page_table = (const int*)args.in[5];
    const float* norm1_g = (const float*)args.in[6]; const float* w_in = (const float*)args.in[7];
    const float* q_g = (const float*)args.in[8]; const float* k_g = (const float*)args.in[9]; const float* sb_bias = (const float*)args.in[10];
    const float* w_ap = (const float*)args.in[11]; const float* w_pool = (const float*)args.in[12]; const float* pool_scale = (const float*)args.in[13];
    const float* w_out = (const float*)args.in[14]; const float* norm2_g = (const float*)args.in[15]; const float* w_gu = (const float*)args.in[16]; const float* w_down = (const float*)args.in[17];
    float* out = args.out;
    bf16_t* Win_t = (bf16_t*)(ws + WS_WIN); bf16_t* Wap_t = (bf16_t*)(ws + WS_WAP); bf16_t* Wpool_t = (bf16_t*)(ws + WS_WPOOL); bf16_t* Wout_t = (bf16_t*)(ws + WS_WOUT);
    bf16_t* Wgu_t = (bf16_t*)(ws + WS_WGU); bf16_t* Wd_t = (bf16_t*)(ws + WS_WD);
    bf16_t* XN = (bf16_t*)(ws + WS_XN); bf16_t* Qb = (bf16_t*)(ws + WS_Q); bf16_t* Kb = (bf16_t*)(ws + WS_K); bf16_t* Vb = (bf16_t*)(ws + WS_V);
    float* U = (float*)(ws + WS_U); bf16_t* SGA = (bf16_t*)(ws + WS_SGA); bf16_t* SGB = (bf16_t*)(ws + WS_SGB); bf16_t* Pb = (bf16_t*)(ws + WS_P); bf16_t* Ob = (bf16_t*)(ws + WS_O);
    bf16_t* MIX = (bf16_t*)(ws + WS_MIX); bf16_t* HB = (bf16_t*)(ws + WS_HB); float* SS = (float*)(ws + WS_SS); bf16_t* ACT = (bf16_t*)(ws + WS_ACT);
    float* DPO = (float*)(ws + WS_DPO); float* DPW = (float*)(ws + WS_DPW);

    for (int u = tid; u < (LDS_BYTES - LDSCTL_OFF) / 4; u += NWAVES * 64) ((LAS unsigned*)(lds + LDSCTL_OFF))[u] = 0u;
    __syncthreads();
    XcdBarrier bar; bar.bar = ctl + CW_BAR + args.li * XCD_BAR_WORDS; bar.x = 0; bar.st = nullptr;
    if (MK_N_LAUNCHES != N_PHASES) bar = xcd_barrier_post(ctl + CW_BAR + args.li * XCD_BAR_WORDS, MISC + 8);
    const int lo = args.ph_lo, hi_ph = args.ph_hi;
#define IN(k) (lo <= (k) && (k) < hi_ph)
#define BOTH(k) (IN(k) && IN((k) + 1))
#define GRID_BAR() do { if (MK_N_LAUNCHES != N_PHASES) xcd_barrier(bar); } while (0)

    if (IN(0)) {
        LAS float* scr = (LAS float*)(lds + RING_OFF + wave * 16384);
        constexpr int I_IN = (DM / 64) * (INC / 32), I_AP = (AW / 64) * (DM / 32), I_PL = 4 * (256 / 64) * (512 / 32), I_OUT = (DM / 64) * (DM / 32), I_GU = (DM / 64) * (2 * DFF / 32), I_DN = (DFF / 64) * (DM / 32);
        constexpr int NITEMS = I_IN + I_AP + I_PL + I_OUT + I_GU + I_DN;
        for (int it = gw; it < NITEMS; it += NGW) {
            int r = it;
            if (r < I_IN) { const int nblk = INC / 32, kb = r / nblk, nb = r % nblk, P0 = 32 * nb, pn = P0 >> 8, bj = (P0 >> 7) & 1, wc = (P0 >> 5) & 3, n0 = 256 * pn + 64 * wc + 32 * bj;
                p0_transpose_item(w_in + (size_t)(64 * kb) * INC + n0, INC, Win_t + (size_t)P0 * DM + 64 * kb, DM, nullptr, scr, lane); continue; } r -= I_IN;
            if (r < I_AP) { const int nblk = DM / 32, kb = r / nblk, nb = r % nblk;
                p0_transpose_item(w_ap + (size_t)(64 * kb) * DM + 32 * nb, DM, Wap_t + (size_t)(32 * nb) * AW + 64 * kb, AW, nullptr, scr, lane); continue; } r -= I_AP;
            if (r < I_PL) { const int gp = r / 64, r2 = r % 64, kb = r2 / 16, nb = r2 % 16;
                p0_transpose_item(w_pool + (size_t)gp * 256 * 512 + (size_t)(64 * kb) * 512 + 32 * nb, 512, Wpool_t + (size_t)(512 * gp + 32 * nb) * 256 + 64 * kb, 256, nullptr, scr, lane); continue; } r -= I_PL;
            if (r < I_OUT) { const int nblk = DM / 32, kb = r / nblk, nb = r % nblk;
                p0_transpose_item(w_out + (size_t)(64 * kb) * DM + 32 * nb, DM, Wout_t + (size_t)(32 * nb) * DM + 64 * kb, DM, nullptr, scr, lane); continue; } r -= I_OUT;
            if (r < I_GU) { const int nblk = 2 * DFF / 32, kb = r / nblk, nb = r % nblk, P0 = 32 * nb, pn = P0 >> 8, bj = (P0 >> 7) & 1, i0 = P0 & 127, n0 = bj * DFF + 128 * pn + i0;
                p0_transpose_item(w_gu + (size_t)(64 * kb) * (2 * DFF) + n0, 2 * DFF, Wgu_t + (size_t)P0 * DM + 64 * kb, DM, norm2_g + 64 * kb, scr, lane); continue; } r -= I_GU;
            { const int nblk = DM / 32, kb = r / nblk, nb = r % nblk;
                p0_transpose_item(w_down + (size_t)(64 * kb) * DM + 32 * nb, DM, Wd_t + (size_t)(32 * nb) * DFF + 64 * kb, DFF, nullptr, scr, lane); }
        }
        for (int mrow = gw; mrow < MPAD; mrow += NGW) {
            unsigned long long* o8 = (unsigned long long*)(XN + (size_t)mrow * DM) + lane;
            if (mrow < MR) {
                const float* xrow = mrow < MP ? x_p + (size_t)mrow * DM : x_s + (size_t)(mrow - MP) * DM;
                const f32x4* xr = (const f32x4*)xrow + lane;
                f32x4 v[8]; float s = 0.f;
#pragma unroll
                for (int j = 0; j < 8; ++j) { v[j] = xr[64 * j]; s += (v[j][0] * v[j][0] + v[j][1] * v[j][1]) + (v[j][2] * v[j][2] + v[j][3] * v[j][3]); }
                const float rstd = rsqrtf(wave_sum(s) * (1.0f / DM) + EPS);
#pragma unroll
                for (int j = 0; j < 8; ++j) { const f32x4 gg = *((const f32x4*)norm1_g + lane + 64 * j); const f32x4 y = v[j] * rstd * gg;
                    o8[64 * j] = (unsigned long long)cvtpk(y[0], y[1]) | ((unsigned long long)cvtpk(y[2], y[3]) << 32); }
            } else {
#pragma unroll
                for (int j = 0; j < 8; ++j) o8[64 * j] = 0ull;
            }
        }
        if (BOTH(0)) GRID_BAR();
    }

    if (IN(1)) {
        pg8::Gemm g{XN, Win_t, DM, DM, DM, 0, 0}; pg8::StaticOrder S; S.init(MPAD, INC, G, bx);
        pg8::EpiIn E{Qb, Kb, Vb, SGA, SGB, U, out, q_g, k_g};
        pg8::gemm_phase<pg8::EpiIn, pg8::StaticOrder>(lds + RING_OFF, g, S, E);
        if (BOTH(1)) GRID_BAR();
    }

    if (IN(2)) {
        for (int it = gw; it < (MP / 32) * 4; it += NGW) {
            const int rb = it >> 2, gp = it & 3, w = 2 << gp, row0 = rb * 32, pos0 = row0 & (SEQ - 1), c = 256 * gp + 4 * lane;
            const float* up = U + (size_t)row0 * PW + c;
            f32x4 s = (f32x4){0.f, 0.f, 0.f, 0.f};
            for (int j = 1; j < w; ++j) if (pos0 - j >= 0) s += *(const f32x4*)(up - (long)j * PW);
            for (int i = 0; i < 32; ++i) {
                const int pos = pos0 + i;
                const f32x4 ut = *(const f32x4*)(up + (size_t)i * PW);
                s += ut;
                const float cnt = (float)(pos + 1 < w ? pos + 1 : w);
                const f32x4 p = s / cnt - ut;
                *(u32x2*)(Pb + (size_t)(row0 + i) * PW + c) = (u32x2){cvtpk(p[0], p[1]), cvtpk(p[2], p[3])};
                if (pos - (w - 1) >= 0) s -= *(const f32x4*)(up + (long)(i - (w - 1)) * PW);
                if (pos >= SEQ - PSTATE) *(f32x4*)(out + OFF_PP + ((size_t)(row0 / SEQ) * PSTATE + (pos - (SEQ - PSTATE))) * PW + c) = ut;
            }
        }
        for (int it = gw; it < DB * 4; it += NGW) {
            const int b = it >> 2, gp = it & 3, w = 2 << gp, c = 256 * gp + 4 * lane;
            const float* st = state_pool + (size_t)b * PSTATE * PW + c; const float* un = U + (size_t)(MP + b * DS) * PW + c;
            for (int i = 0; i < DS; ++i) {
                f32x4 s = (f32x4){0.f, 0.f, 0.f, 0.f};
                for (int j = 0; j < w; ++j) { const int e = PSTATE + i - j; s += e >= PSTATE ? *(const f32x4*)(un + (size_t)(e - PSTATE) * PW) : *(const f32x4*)(st + (size_t)e * PW); }
                const f32x4 ut = *(const f32x4*)(un + (size_t)i * PW);
                const f32x4 p = s / (float)w - ut;
                *(u32x2*)(Pb + (size_t)(MP + b * DS + i) * PW + c) = (u32x2){cvtpk(p[0], p[1]), cvtpk(p[2], p[3])};
            }
            for (int j = 0; j < PSTATE; ++j) { const int e = DS + j;
                *(f32x4*)(out + OFF_PS + ((size_t)b * PSTATE + j) * PW + c) = e >= PSTATE ? *(const f32x4*)(un + (size_t)(e - PSTATE) * PW) : *(const f32x4*)(st + (size_t)e * PW); }
        }
        __syncthreads();
        for (int half = 0; half < 2; ++half) {
            if ((half == 0) == ((vcu & 1) == 0)) {
                for (int id = vcu; id < DB * DCH; id += G) att::decode_unit(id / DCH, id % DCH, Qb, cache_k, cache_v, page_table, sb_bias, DPO, DPW, lds + RING_OFF);
            } else {
                for (int pi = vcu; pi < NB * NH * 8; pi += G) { const int bh = pi >> 3, s = pi & 7;
                    att::prompt_unit(bh / NH, bh % NH, s, Qb, Kb, Vb, Ob, sb_bias, lds + RING_OFF);
                    att::prompt_unit(bh / NH, bh % NH, 15 - s, Qb, Kb, Vb, Ob, sb_bias, lds + RING_OFF); }
            }
            __syncthreads();
        }
        if (BOTH(2)) GRID_BAR();
    }

    if (IN(3)) {
        for (int id = gw; id < DB * NH * DS; id += NGW) {
            const int b = id / (NH * DS), h = (id / DS) % NH, i = id % DS;
            const size_t r0 = (size_t)(MP + b * DS);
            const float qd = bflo((unsigned)Qb[(r0 + i) * AW + h * HD + lane]);
            const float bias2 = sb_bias[h] * LOG2E;
            float carry = 1.0f, o = 0.f;
            for (int j = i - 1; j >= 0; --j) {
                const float kd = bflo((unsigned)Kb[(r0 + j) * AW + h * HD + lane]), vd = bflo((unsigned)Vb[(r0 + j) * AW + h * HD + lane]);
                const float z2 = wave_sum(qd * kd) + bias2;
                const float e = __builtin_amdgcn_exp2f(z2), w = __builtin_amdgcn_rcpf(1.0f + e);
                carry *= w; o += e * carry * vd;
            }
            const float* op = DPO + (((size_t)b * NH + h) * DCH * DS + i) * HD + lane; const float* wp = DPW + ((size_t)b * NH + h) * DCH * DS + i;
            for (int c = DCH - 1; c >= 0; --c) { o += carry * op[(size_t)c * DS * HD]; carry *= wp[c * DS]; }
            Ob[(r0 + i) * AW + h * HD + lane] = (bf16_t)(cvtpk(o, 0.f) & 0xffffu);
        }
        if (BOTH(3)) GRID_BAR();
    }

    if (IN(4)) {
        pg8::StaticOrder S; S.init(MPAD, DM, G, bx);
        { pg8::Gemm g{Pb, Wpool_t, PW, 256, 256, 1, 256}; pg8::EpiPool E{SGB, pool_scale, MIX};
          pg8::gemm_phase<pg8::EpiPool, pg8::StaticOrder>(lds + RING_OFF, g, S, E); }
        { pg8::Gemm g{Ob, Wap_t, AW, AW, AW, 0, 0}; pg8::EpiProj E{SGA, MIX};
          pg8::gemm_phase<pg8::EpiProj, pg8::StaticOrder>(lds + RING_OFF, g, S, E); }
        if (BOTH(4)) GRID_BAR();
    }

    if (IN(5)) {
        pg8::Gemm g{MIX, Wout_t, DM, DM, DM, 0, 0}; pg8::StaticOrder S; S.init(MPAD, DM, G, bx);
        pg8::EpiOut E{x_p, x_s, out, HB, SS};
        pg8::gemm_phase<pg8::EpiOut, pg8::StaticOrder>(lds + RING_OFF, g, S, E);
        if (BOTH(5)) GRID_BAR();
    }

    if (IN(6)) {
        pg8::Gemm g{HB, Wgu_t, DM, DM, DM, 0, 0}; pg8::StaticOrder S; S.init(MPAD, 2 * DFF, G, bx);
        pg8::EpiGU E{SS, ACT};
        pg8::gemm_phase<pg8::EpiGU, pg8::StaticOrder>(lds + RING_OFF, g, S, E);
        if (BOTH(6)) GRID_BAR();
    }

    if (IN(7)) {
        pg8::Gemm g{ACT, Wd_t, DFF, DFF, DFF, 0, 0}; pg8::StaticOrder S; S.init(MPAD, DM, G, bx);
        pg8::EpiDown E{out};
        pg8::gemm_phase<pg8::EpiDown, pg8::StaticOrder>(lds + RING_OFF, g, S, E);
    }
#undef IN
#undef BOTH
#undef GRID_BAR
}

extern "C" void kernel_launch(void* const* d_in, const int* in_sizes, int n_in, void* d_out, int out_size, void* d_ws, size_t ws_size, hipStream_t stream) {
    static int grid = 0;
    if (grid == 0) {
        if (n_in != 18 || (size_t)out_size != OUT_TOTAL || ws_size < WS_END) { fprintf(stderr, "kernel_launch: unexpected sizes (n_in %d, out %d, ws %zu)\n", n_in, out_size, ws_size); grid = -1; return; }
        int dev = 0, cus = 0, per_cu = 0;
        if (hipGetDevice(&dev) != hipSuccess || hipDeviceGetAttribute(&cus, hipDeviceAttributeMultiprocessorCount, dev) != hipSuccess) { grid = -1; return; }
        if (hipFuncSetAttribute((const void*)fwd_kernel, hipFuncAttributeMaxDynamicSharedMemorySize, LDS_BYTES) != hipSuccess) { fprintf(stderr, "kernel_launch: hipFuncSetAttribute failed\n"); grid = -1; return; }
        if (hipOccupancyMaxActiveBlocksPerMultiprocessor(&per_cu, (const void*)fwd_kernel, NWAVES * 64, LDS_BYTES) != hipSuccess || per_cu < 1)
            fprintf(stderr, "kernel_launch: occupancy query reports %d workgroups per CU\n", per_cu);
        (void)hipGetLastError();
        grid = cus;
    }
    if (grid < 0) return;
    if (hipMemsetAsync((char*)d_ws + WS_CTL, 0, CTL_ZERO_BYTES, stream) != hipSuccess) return;
    Args a{};
    for (int i = 0; i < 18; ++i) a.in[i] = d_in[i];
    a.out = (float*)d_out; a.ws = (unsigned char*)d_ws;
    if (MK_N_LAUNCHES == N_PHASES) {
        for (int li = 0; li < N_PHASES; ++li) { a.ph_lo = li; a.ph_hi = li + 1; a.li = 0; hipLaunchKernelGGL(fwd_kernel, dim3(grid), dim3(NWAVES * 64), LDS_BYTES, stream, a); }
    } else {
        a.ph_lo = 0; a.ph_hi = N_PHASES; a.li = 0;
        hipLaunchKernelGGL(fwd_kernel, dim3(grid), dim3(NWAVES * 64), LDS_BYTES, stream, a);
    }
}
```

```cpp
#include <hip/hip_runtime.h>
#include <cstdio>
#include <cstdint>

#define LAS __attribute__((address_space(3)))
#define GAS __attribute__((address_space(1)))
typedef unsigned short bf16_t;
typedef short bf16x8 __attribute__((ext_vector_type(8)));
typedef short s16x4 __attribute__((ext_vector_type(4)));
typedef float f32x2 __attribute__((ext_vector_type(2)));
typedef float f32x4 __attribute__((ext_vector_type(4)));
typedef float f32x16 __attribute__((ext_vector_type(16)));
typedef unsigned u32x2 __attribute__((ext_vector_type(2)));
typedef unsigned u32x4 __attribute__((ext_vector_type(4)));
typedef __bf16 bf16x2_t __attribute__((ext_vector_type(2)));

#ifndef MK_N_LAUNCHES
#define MK_N_LAUNCHES 1
#endif
#ifndef PROBE_PH
#define PROBE_PH -1
#endif

constexpr int DM = 2048, NB = 2, SEQ = 4096, MP = NB * SEQ, DB = 8, DS = 4, MS = DB * DS, MR = MP + MS, MPAD = 8448;
constexpr int NH = 16, HD = 64, AW = 1024, PW = 1024, DFF = 5632, INC = 8192;
constexpr int PAST = 16384, PAGE = 128, NPG = PAST / PAGE, PSTATE = 15;
constexpr int DCH = 32;
constexpr float LOG2E = 1.4426950408889634f, C2 = 0.125f * LOG2E, EPS = 1e-6f;
constexpr size_t OFF_YP = 0, OFF_YS = (size_t)MP * DM, OFF_KP = OFF_YS + (size_t)MS * DM, OFF_VP = OFF_KP + (size_t)MP * AW, OFF_PP = OFF_VP + (size_t)MP * AW,
                 OFF_KS = OFF_PP + (size_t)NB * PSTATE * PW, OFF_VS = OFF_KS + (size_t)MS * AW, OFF_PS = OFF_VS + (size_t)MS * AW, OUT_TOTAL = OFF_PS + (size_t)DB * PSTATE * PW;

__device__ __forceinline__ unsigned cvtpk(float lo, float hi) { f32x2 v = {lo, hi}; bf16x2_t b = __builtin_convertvector(v, bf16x2_t); return __builtin_bit_cast(unsigned, b); }
__device__ __forceinline__ float bflo(unsigned u) { return __uint_as_float(u << 16); }
__device__ __forceinline__ float bfhi(unsigned u) { return __uint_as_float(u & 0xffff0000u); }
__device__ __forceinline__ u32x4 pack8(const f32x4 a, const f32x4 b) { u32x4 w; w.x = cvtpk(a[0], a[1]); w.y = cvtpk(a[2], a[3]); w.z = cvtpk(b[0], b[1]); w.w = cvtpk(b[2], b[3]); return w; }
__device__ __forceinline__ void unpack8(const u32x4 w, f32x4& a, f32x4& b) { a = (f32x4){bflo(w.x), bfhi(w.x), bflo(w.y), bfhi(w.y)}; b = (f32x4){bflo(w.z), bfhi(w.z), bflo(w.w), bfhi(w.w)}; }
__device__ __forceinline__ float sigm(float x) { return 1.0f / (1.0f + __expf(-x)); }

namespace pg8 {
constexpr int BM = 256, BK = 64, HALF = 128, HTB = HALF * BK * 2  , STAGE_BYTES = 8 * HTB, NXCD = 8, WGM = 8;
__host__ __device__ __forceinline__ int lds_byte(int r, int c) { const int st = (r >> 4) * 2 + (c >> 5), rr = r & 15, cc = c & 31, ob = rr * 64 + cc * 2; return st * 1024 + (ob ^ (((ob >> 9) & 1) << 5)); }
__host__ __device__ __forceinline__ void stage_rc(int b, int& R, int& C) { const int st = b / 1024, sb = b % 1024, swz = sb ^ (((sb >> 9) & 1) << 5); R = (st >> 1) * 16 + swz / 64; C = (st & 1) * 32 + (swz % 64) / 2; }
__host__ __device__ __forceinline__ int perm32(int rho) { const int n = rho >> 4, i = rho & 15; return 8 * (i >> 2) + 4 * n + (i & 3); }

struct Unit { int pm, pn; };
struct Gemm { const bf16_t* A; const bf16_t* Bt; int lda, ldb, K, agrp_shift, agrp_stride; };

struct StaticOrder {
    int nM, nN, nwg, G, c;
    __host__ __device__ void init(int M, int N, int G_, int c_) { nM = M / BM; nN = N / BM; nwg = nM * nN; G = G_; c = c_; }
    __host__ __device__ bool next(int i, Unit& u) const {
        const long L = (long)i * G + c; if (L >= nwg) return false;
        int wgid = (int)L; { const int q = nwg / NXCD, r = nwg % NXCD, xcd = wgid % NXCD, off = wgid / NXCD; wgid = (xcd < r ? xcd * (q + 1) : r * (q + 1) + (xcd - r) * q) + off; }
        const int nig = WGM * nN, gid = wgid / nig, fm = gid * WGM, gsz = (nM - fm) < WGM ? (nM - fm) : WGM;
        u.pm = fm + ((wgid % nig) % gsz); u.pn = (wgid % nig) / gsz; return true;
    }
    __device__ __forceinline__ void a_ready(const Unit&) const {}
    __device__ __forceinline__ void done(const Unit&) const {}
};

template <class Epi, class Sched>
__device__ __forceinline__ void gemm_phase(LAS unsigned char* lds, const Gemm g, const Sched& S, const Epi& E) {
    const int tid = threadIdx.x, wid = __builtin_amdgcn_readfirstlane(tid >> 6), lane = tid & 63, wr = wid >> 2, wc = wid & 3, fr = lane & 15, fq = lane >> 4;
    int nt = g.K / BK; asm volatile("" : "+s"(nt));
    unsigned voffA[2], voffB[2];
#pragma unroll
    for (int i = 0; i < 2; ++i) { int R, C; stage_rc(tid * 16 + i * 8192, R, C); const int Rb = Epi::PERM ? ((R & ~31) + perm32(R & 31)) : R;
        voffA[i] = (unsigned)(R * g.lda + C) * 2u; voffB[i] = (unsigned)(Rb * g.ldb + C) * 2u; }
    const size_t kstep = (size_t)(BK * 2);
    const size_t hstepA = (size_t)HALF * g.lda * 2, hstepB = (size_t)HALF * g.ldb * 2;
    const size_t tstepA = 2 * hstepA, tstepB = 2 * hstepB;
    const unsigned ldsw = (unsigned)wid * 1024u;
    const int aoff = lds_byte(wr * 64 + fr, fq * 8), boff = lds_byte(wc * 32 + fr, fq * 8);
#define PG8_SA(b, h) (((b) * 2 + (h)) * HTB)
#define PG8_SB(b, h) ((4 + (b) * 2 + (h)) * HTB)
#define PG8_STAGE(bufoff, gbase, voff) do { _Pragma("unroll") for (int _i = 0; _i < 2; ++_i) \
        __builtin_amdgcn_global_load_lds((const unsigned*)((const char*)(gbase) + (voff)[_i]), (LAS unsigned*)(lds + (bufoff) + ldsw + _i * 8192), 16, 0, 0); } while (0)
#define PG8_LDA(dst, b, h) do { _Pragma("unroll") for (int m = 0; m < 4; ++m) _Pragma("unroll") for (int k = 0; k < 2; ++k) dst[m][k] = *(const LAS bf16x8*)(lds + PG8_SA(b, h) + aoff + m * 2048 + k * 1024); } while (0)
#define PG8_LDB(dst, b, h) do { _Pragma("unroll") for (int n = 0; n < 2; ++n) _Pragma("unroll") for (int k = 0; k < 2; ++k) dst[n][k] = *(const LAS bf16x8*)(lds + PG8_SB(b, h) + boff + n * 2048 + k * 1024); } while (0)
#define PG8_MMA(ai, bj, At, Bt) do { __builtin_amdgcn_s_setprio(1); _Pragma("unroll") for (int m = 0; m < 4; ++m) _Pragma("unroll") for (int n = 0; n < 2; ++n) _Pragma("unroll") for (int k = 0; k < 2; ++k) \
        acc[ai][bj][m][n] = __builtin_amdgcn_mfma_f32_16x16x32_bf16(Bt[n][k], At[m][k], acc[ai][bj][m][n], 0, 0, 0); __builtin_amdgcn_s_setprio(0); } while (0)
#define PG8_WAIT_V(n) asm volatile("s_waitcnt vmcnt(" #n ")" ::: "memory")
#define PG8_WAIT_L(n) asm volatile("s_waitcnt lgkmcnt(" #n ")" ::: "memory")
#define PG8_BAR __builtin_amdgcn_s_barrier()
#define PG8_SCHED __builtin_amdgcn_sched_barrier(0)
#define PG8_ABASE(u) ((const char*)g.A + (size_t)(u).pm * tstepA + (size_t)(((u).pn >> g.agrp_shift) * g.agrp_stride) * 2)
    Unit cur, nxt; int ui = 0;
    if (!S.next(0, cur)) return;
    f32x4 acc[2][2][4][2];
#pragma unroll
    for (int a = 0; a < 2; ++a)
#pragma unroll
        for (int b = 0; b < 2; ++b)
#pragma unroll
            for (int m = 0; m < 4; ++m)
#pragma unroll
                for (int n = 0; n < 2; ++n) acc[a][b][m][n] = (f32x4){0.f, 0.f, 0.f, 0.f};
    bf16x8 At[4][2], B0[2][2], B1[2][2];
    const char* cA = PG8_ABASE(cur); const char* cB = (const char*)g.Bt + (size_t)cur.pn * tstepB;
    S.a_ready(cur);
    PG8_STAGE(PG8_SB(0, 0), cB, voffB); PG8_STAGE(PG8_SB(0, 1), cB + hstepB, voffB); PG8_STAGE(PG8_SA(0, 0), cA, voffA); PG8_STAGE(PG8_SA(0, 1), cA + hstepA, voffA);
    if (wr == 1) PG8_BAR;
    PG8_WAIT_V(2); PG8_BAR;
    PG8_STAGE(PG8_SB(1, 0), cB + kstep, voffB); PG8_STAGE(PG8_SA(1, 0), cA + kstep, voffA); PG8_STAGE(PG8_SB(1, 1), cB + hstepB + kstep, voffB);
    PG8_WAIT_V(6); PG8_BAR;
    for (;;) {
        const bool has_next = S.next(ui + 1, nxt);
        const char* nA = has_next ? PG8_ABASE(nxt) : cA; const char* nB = has_next ? (const char*)g.Bt + (size_t)nxt.pn * tstepB : cB;
        for (int t = 0; t < nt; t += 2) {
            const bool last = (t == nt - 2);
            const char* a1 = cA + (size_t)(t + 1) * kstep;
            const char* a2 = last ? nA : cA + (size_t)(t + 2) * kstep; const char* b2 = last ? nB : cB + (size_t)(t + 2) * kstep;
            const char* a3 = a2 + kstep; const char* b3 = b2 + kstep;
            if (last && has_next) S.a_ready(nxt);
            PG8_LDB(B0, 0, 0); PG8_LDB(B1, 0, 1); PG8_SCHED; PG8_LDA(At, 0, 0); PG8_STAGE(PG8_SA(1, 1), a1 + hstepA, voffA);
            PG8_WAIT_V(8); PG8_WAIT_L(0); PG8_BAR; PG8_MMA(0, 0, At, B0); PG8_MMA(0, 1, At, B1); PG8_BAR; PG8_SCHED;
            PG8_LDA(At, 0, 1); PG8_STAGE(PG8_SB(0, 0), b2, voffB); PG8_STAGE(PG8_SB(0, 1), b2 + hstepB, voffB); PG8_STAGE(PG8_SA(0, 0), a2, voffA);
            PG8_WAIT_V(8); PG8_WAIT_L(0); PG8_BAR; PG8_MMA(1, 0, At, B0); PG8_MMA(1, 1, At, B1); PG8_BAR; PG8_SCHED;
            PG8_LDB(B0, 1, 0); PG8_LDB(B1, 1, 1); PG8_SCHED; PG8_LDA(At, 1, 0); PG8_STAGE(PG8_SA(0, 1), a2 + hstepA, voffA);
            PG8_WAIT_V(8); PG8_WAIT_L(0); PG8_BAR; PG8_MMA(0, 0, At, B0); PG8_MMA(0, 1, At, B1); PG8_BAR; PG8_SCHED;
            PG8_LDA(At, 1, 1); PG8_STAGE(PG8_SB(1, 0), b3, voffB); PG8_STAGE(PG8_SB(1, 1), b3 + hstepB, voffB); PG8_STAGE(PG8_SA(1, 0), a3, voffA);
            PG8_WAIT_V(8); PG8_WAIT_L(0); PG8_BAR; PG8_MMA(1, 0, At, B0); PG8_MMA(1, 1, At, B1); PG8_BAR; PG8_SCHED;
        }
        if (wr == 0) PG8_BAR;
        E(acc, cur, wr, wc, fr, fq); S.done(cur);
        if (!has_next) break;
#pragma unroll
        for (int a = 0; a < 2; ++a)
#pragma unroll
            for (int b = 0; b < 2; ++b)
#pragma unroll
                for (int m = 0; m < 4; ++m)
#pragma unroll
                    for (int n = 0; n < 2; ++n) acc[a][b][m][n] = (f32x4){0.f, 0.f, 0.f, 0.f};
        cur = nxt; cA = nA; cB = nB; ++ui;
        if (wr == 1) PG8_BAR;
    }
    PG8_WAIT_V(0);
    PG8_BAR;
#undef PG8_SA
#undef PG8_SB
#undef PG8_STAGE
#undef PG8_LDA
#undef PG8_LDB
#undef PG8_MMA
#undef PG8_WAIT_V
#undef PG8_WAIT_L
#undef PG8_BAR
#undef PG8_SCHED
#undef PG8_ABASE
}

#define EPI_ROWS_BEGIN _Pragma("unroll") for (int ai = 0; ai < 2; ++ai) _Pragma("unroll") for (int m = 0; m < 4; ++m) { \
        const int row0 = u.pm * BM + ai * HALF + wr * 64 + m * 16; if (row0 < MR) { const int row = row0 + fr;
#define EPI_ROWS_END } }

struct EpiIn {
    static constexpr bool PERM = true;
    bf16_t *Q, *Kb, *Vb, *SGA, *SGB; float* U; float* out; const float *qg, *kg;
    __device__ __forceinline__ void operator()(const f32x4 (&acc)[2][2][4][2], const Unit& u, int wr, int wc, int fr, int fq) const {
        const int kind = u.pn >> 2;
        EPI_ROWS_BEGIN
            if (kind <= 1) {
                float ss = 0.f;
#pragma unroll
                for (int bj = 0; bj < 2; ++bj)
#pragma unroll
                    for (int n = 0; n < 2; ++n) { const f32x4 x = acc[ai][bj][m][n]; ss += (x[0] * x[0] + x[1] * x[1]) + (x[2] * x[2] + x[3] * x[3]); }
                ss += __shfl_xor(ss, 16); ss += __shfl_xor(ss, 32);
                const float sc = rsqrtf(ss * (1.0f / 64.0f) + EPS) * (kind == 0 ? C2 : 1.0f);
                const float* g = kind == 0 ? qg : kg;
                const int head = (u.pn & 3) * 4 + wc;
                float* kn = row0 < MP ? out + OFF_KP + (size_t)row * AW : out + OFF_KS + (size_t)(row - MP) * AW;
#pragma unroll
                for (int bj = 0; bj < 2; ++bj) {
                    const int d0 = 32 * bj + 8 * fq, col = head * 64 + d0;
                    const f32x4 g0 = *(const f32x4*)(g + d0), g1 = *(const f32x4*)(g + d0 + 4);
                    const f32x4 v0 = acc[ai][bj][m][0] * sc * g0, v1 = acc[ai][bj][m][1] * sc * g1;
                    if (kind == 0) { *(u32x4*)(Q + (size_t)row * AW + col) = pack8(v0, v1); }
                    else { *(f32x4*)(kn + col) = v0; *(f32x4*)(kn + col + 4) = v1; *(u32x4*)(Kb + (size_t)row * AW + col) = pack8(v0, v1); }
                }
            } else if (kind == 2) {
                float* vn = row0 < MP ? out + OFF_VP + (size_t)row * AW : out + OFF_VS + (size_t)(row - MP) * AW;
#pragma unroll
                for (int bj = 0; bj < 2; ++bj) {
                    const int col = (u.pn - 8) * 256 + 64 * wc + 32 * bj + 8 * fq;
                    const f32x4 v0 = acc[ai][bj][m][0], v1 = acc[ai][bj][m][1];
                    *(f32x4*)(vn + col) = v0; *(f32x4*)(vn + col + 4) = v1; *(u32x4*)(Vb + (size_t)row * AW + col) = pack8(v0, v1);
                }
            } else if (kind == 3) {
#pragma unroll
                for (int bj = 0; bj < 2; ++bj) {
                    const int col = (u.pn - 12) * 256 + 64 * wc + 32 * bj + 8 * fq;
                    *(f32x4*)(U + (size_t)row * PW + col) = acc[ai][bj][m][0]; *(f32x4*)(U + (size_t)row * PW + col + 4) = acc[ai][bj][m][1];
                }
            } else {
                bf16_t* S = kind < 6 ? SGA : SGB;
                const int cb = (kind < 6 ? u.pn - 16 : u.pn - 24) * 256;
#pragma unroll
                for (int bj = 0; bj < 2; ++bj) {
                    const int col = cb + 64 * wc + 32 * bj + 8 * fq;
                    f32x4 v0 = acc[ai][bj][m][0], v1 = acc[ai][bj][m][1];
#pragma unroll
                    for (int e = 0; e < 4; ++e) { v0[e] = sigm(v0[e]); v1[e] = sigm(v1[e]); }
                    *(u32x4*)(S + (size_t)row * DM + col) = pack8(v0, v1);
                }
            }
        EPI_ROWS_END
    }
};
struct EpiPool {
    static constexpr bool PERM = true;
    const bf16_t* SGB; const float* ps; bf16_t* MIX;
    __device__ __forceinline__ void operator()(const f32x4 (&acc)[2][2][4][2], const Unit& u, int wr, int wc, int fr, int fq) const {
        EPI_ROWS_BEGIN
#pragma unroll
            for (int bj = 0; bj < 2; ++bj) {
                const int col = u.pn * BM + bj * HALF + wc * 32 + 8 * fq;
                f32x4 s0, s1; unpack8(*(const u32x4*)(SGB + (size_t)row * DM + col), s0, s1);
                const f32x4 p0 = *(const f32x4*)(ps + col), p1 = *(const f32x4*)(ps + col + 4);
                *(u32x4*)(MIX + (size_t)row * DM + col) = pack8(acc[ai][bj][m][0] * p0 * s0, acc[ai][bj][m][1] * p1 * s1);
            }
        EPI_ROWS_END
    }
};
struct EpiProj {
    static constexpr bool PERM = true;
    const bf16_t* SGA; bf16_t* MIX;
    __device__ __forceinline__ void operator()(const f32x4 (&acc)[2][2][4][2], const Unit& u, int wr, int wc, int fr, int fq) const {
        EPI_ROWS_BEGIN
#pragma unroll
            for (int bj = 0; bj < 2; ++bj) {
                const int col = u.pn * BM + bj * HALF + wc * 32 + 8 * fq;
                f32x4 s0, s1, q0, q1; unpack8(*(const u32x4*)(SGA + (size_t)row * DM + col), s0, s1); unpack8(*(const u32x4*)(MIX + (size_t)row * DM + col), q0, q1);
                *(u32x4*)(MIX + (size_t)row * DM + col) = pack8(acc[ai][bj][m][0] * s0 + q0, acc[ai][bj][m][1] * s1 + q1);
            }
        EPI_ROWS_END
    }
};
struct EpiOut {
    static constexpr bool PERM = true;
    const float *xp, *xs; float* H; bf16_t* HB; float* SS;
    __device__ __forceinline__ void operator()(const f32x4 (&acc)[2][2][4][2], const Unit& u, int wr, int wc, int fr, int fq) const {
        EPI_ROWS_BEGIN
            const float* xr = row0 < MP ? xp + (size_t)row * DM : xs + (size_t)(row - MP) * DM;
            float ss = 0.f;
#pragma unroll
            for (int bj = 0; bj < 2; ++bj) {
                const int col = u.pn * BM + bj * HALF + wc * 32 + 8 * fq;
                const f32x4 h0 = *(const f32x4*)(xr + col) + acc[ai][bj][m][0], h1 = *(const f32x4*)(xr + col + 4) + acc[ai][bj][m][1];
                *(f32x4*)(H + (size_t)row * DM + col) = h0; *(f32x4*)(H + (size_t)row * DM + col + 4) = h1;
                *(u32x4*)(HB + (size_t)row * DM + col) = pack8(h0, h1);
                ss += (h0[0] * h0[0] + h0[1] * h0[1]) + (h0[2] * h0[2] + h0[3] * h0[3]) + (h1[0] * h1[0] + h1[1] * h1[1]) + (h1[2] * h1[2] + h1[3] * h1[3]);
            }
            ss += __shfl_xor(ss, 16); ss += __shfl_xor(ss, 32);
            if (fq == 0) SS[(size_t)row * 32 + u.pn * 4 + wc] = ss;
        EPI_ROWS_END
    }
};
struct EpiGU {
    static constexpr bool PERM = true;
    const float* SS; bf16_t* ACT;
    __device__ __forceinline__ void operator()(const f32x4 (&acc)[2][2][4][2], const Unit& u, int wr, int wc, int fr, int fq) const {
        EPI_ROWS_BEGIN
            const f32x4* sp = (const f32x4*)(SS + (size_t)row * 32);
            f32x4 t = sp[0];
#pragma unroll
            for (int j = 1; j < 8; ++j) t += sp[j];
            const float rstd = rsqrtf(((t[0] + t[1]) + (t[2] + t[3])) * (1.0f / DM) + EPS);
            const int col = u.pn * HALF + wc * 32 + 8 * fq;
            f32x4 a0, a1;
#pragma unroll
            for (int e = 0; e < 4; ++e) { const float g0 = acc[ai][0][m][0][e] * rstd, g1 = acc[ai][0][m][1][e] * rstd;
                a0[e] = g0 * sigm(g0) * (acc[ai][1][m][0][e] * rstd); a1[e] = g1 * sigm(g1) * (acc[ai][1][m][1][e] * rstd); }
            *(u32x4*)(ACT + (size_t)row * DFF + col) = pack8(a0, a1);
        EPI_ROWS_END
    }
};
struct EpiDown {
    static constexpr bool PERM = true;
    float* H;
    __device__ __forceinline__ void operator()(const f32x4 (&acc)[2][2][4][2], const Unit& u, int wr, int wc, int fr, int fq) const {
        EPI_ROWS_BEGIN
#pragma unroll
            for (int bj = 0; bj < 2; ++bj) {
                float* hp = H + (size_t)row * DM + u.pn * BM + bj * HALF + wc * 32 + 8 * fq;
                const f32x4 y0 = *(const f32x4*)hp + acc[ai][bj][m][0], y1 = *(const f32x4*)(hp + 4) + acc[ai][bj][m][1];
                *(f32x4*)hp = y0; *(f32x4*)(hp + 4) = y1;
            }
        EPI_ROWS_END
    }
};
}


namespace sk {
constexpr int PSTR = 68, PART_FLOATS = 32 * PSTR, RED_OFF = 8 * PART_FLOATS * 4;
template <class Epi>
__device__ __forceinline__ void unit(LAS unsigned char* lds, const bf16_t* A, int lda, const bf16_t* B0, const bf16_t* B1, int ldb, int K, const Epi& E, int j) {
    const int tid = threadIdx.x, lane = tid & 63, r32 = lane & 31, hi = lane >> 5; const int wid = __builtin_amdgcn_readfirstlane(tid >> 6);
    const int kc = K >> 3;
    const bf16_t* ap = A + (size_t)r32 * lda + wid * kc + hi * 8;
    const bf16_t* b0 = B0 + (size_t)r32 * ldb + wid * kc + hi * 8;
    const bf16_t* b1 = B1 + (size_t)r32 * ldb + wid * kc + hi * 8;
    f32x16 acc0 = f32x16{}, acc1 = f32x16{};
#pragma unroll 4
    for (int k = 0; k < kc; k += 16) {
        const bf16x8 af = *(const bf16x8*)(ap + k), f0 = *(const bf16x8*)(b0 + k), f1 = *(const bf16x8*)(b1 + k);
        acc0 = __builtin_amdgcn_mfma_f32_32x32x16_bf16(f0, af, acc0, 0, 0, 0);
        acc1 = __builtin_amdgcn_mfma_f32_32x32x16_bf16(f1, af, acc1, 0, 0, 0);
    }
    LAS float* part = (LAS float*)lds + wid * PART_FLOATS + r32 * PSTR + 4 * hi;
#pragma unroll
    for (int g = 0; g < 4; ++g) {
        *(LAS f32x4*)(part + 8 * g) = (f32x4){acc0[4 * g], acc0[4 * g + 1], acc0[4 * g + 2], acc0[4 * g + 3]};
        *(LAS f32x4*)(part + 32 + 8 * g) = (f32x4){acc1[4 * g], acc1[4 * g + 1], acc1[4 * g + 2], acc1[4 * g + 3]};
    }
    __syncthreads();
    { const int m = tid >> 4, c4 = (tid & 15) * 4; const LAS float* pp = (const LAS float*)lds + m * PSTR + c4;
      f32x4 t = *(const LAS f32x4*)pp;
#pragma unroll
      for (int w = 1; w < 8; ++w) t += *(const LAS f32x4*)(pp + w * PART_FLOATS);
      *(LAS f32x4*)((LAS float*)(lds + RED_OFF) + m * PSTR + c4) = t; }
    __syncthreads();
    E.run((const LAS float*)(lds + RED_OFF), j, tid);
}
__device__ __forceinline__ float sum16(float v) { v += __shfl_xor(v, 1); v += __shfl_xor(v, 2); v += __shfl_xor(v, 4); v += __shfl_xor(v, 8); return v; }
__device__ __forceinline__ u32x2 pack4(const f32x4 a) { return (u32x2){cvtpk(a[0], a[1]), cvtpk(a[2], a[3])}; }
__device__ __forceinline__ f32x4 unpack4(const u32x2 w) { return (f32x4){bflo(w.x), bfhi(w.x), bflo(w.y), bfhi(w.y)}; }
struct SkIn {
    bf16_t *Q, *Kb, *Vb, *SGA, *SGB; float* U; float* out; const float *qg, *kg;
    __device__ __forceinline__ void run(const LAS float* red, int j, int tid) const {
        const int m = tid >> 4, c4 = (tid & 15) * 4, kind = j >> 4; const size_t row = MP + m;
        f32x4 v = *(const LAS f32x4*)(red + m * PSTR + c4);
        if (kind <= 1) {
            const float ss = sum16((v[0] * v[0] + v[1] * v[1]) + (v[2] * v[2] + v[3] * v[3]));
            const float sc = rsqrtf(ss * (1.0f / 64.0f) + EPS) * (kind == 0 ? C2 : 1.0f);
            const f32x4 g = *(const f32x4*)((kind == 0 ? qg : kg) + c4);
            v = v * sc * g;
            const int col = (j & 15) * 64 + c4;
            if (kind == 0) *(u32x2*)(Q + row * AW + col) = pack4(v);
            else { *(f32x4*)(out + OFF_KS + (size_t)m * AW + col) = v; *(u32x2*)(Kb + row * AW + col) = pack4(v); }
        } else if (kind == 2) { const int col = (j - 32) * 64 + c4; *(f32x4*)(out + OFF_VS + (size_t)m * AW + col) = v; *(u32x2*)(Vb + row * AW + col) = pack4(v); }
        else if (kind == 3) { *(f32x4*)(U + row * PW + (j - 48) * 64 + c4) = v; }
        else { bf16_t* S = kind < 6 ? SGA : SGB; const int col = (kind < 6 ? j - 64 : j - 96) * 64 + c4;
#pragma unroll
            for (int e = 0; e < 4; ++e) v[e] = sigm(v[e]);
            *(u32x2*)(S + row * DM + col) = pack4(v); }
    }
};
struct SkPool {
    const bf16_t* SGB; const float* ps; bf16_t* MIX;
    __device__ __forceinline__ void run(const LAS float* red, int j, int tid) const {
        const int m = tid >> 4, c4 = (tid & 15) * 4, col = j * 64 + c4; const size_t row = MP + m;
        const f32x4 v = *(const LAS f32x4*)(red + m * PSTR + c4);
        *(u32x2*)(MIX + row * DM + col) = pack4(v * *(const f32x4*)(ps + col) * unpack4(*(const u32x2*)(SGB + row * DM + col)));
    }
};
struct SkProj {
    const bf16_t* SGA; bf16_t* MIX;
    __device__ __forceinline__ void run(const LAS float* red, int j, int tid) const {
        const int m = tid >> 4, c4 = (tid & 15) * 4, col = j * 64 + c4; const size_t row = MP + m;
        const f32x4 v = *(const LAS f32x4*)(red + m * PSTR + c4);
        *(u32x2*)(MIX + row * DM + col) = pack4(v * unpack4(*(const u32x2*)(SGA + row * DM + col)) + unpack4(*(const u32x2*)(MIX + row * DM + col)));
    }
};
struct SkOut {
    const float* xs; float* H; bf16_t* HB; float* SS;
    __device__ __forceinline__ void run(const LAS float* red, int j, int tid) const {
        const int m = tid >> 4, c4 = (tid & 15) * 4, col = j * 64 + c4; const size_t row = MP + m;
        const f32x4 h = *(const LAS f32x4*)(red + m * PSTR + c4) + *(const f32x4*)(xs + (size_t)m * DM + col);
        *(f32x4*)(H + row * DM + col) = h; *(u32x2*)(HB + row * DM + col) = pack4(h);
        const float ss = sum16((h[0] * h[0] + h[1] * h[1]) + (h[2] * h[2] + h[3] * h[3]));
        if ((tid & 15) == 0) SS[row * 32 + j] = ss;
    }
};
struct SkGU {
    const float* SS; bf16_t* ACT;
    __device__ __forceinline__ void run(const LAS float* red, int j, int tid) const {
        if (tid < 256) {
            const int m = tid >> 3, i4 = (tid & 7) * 4; const size_t row = MP + m;
            const f32x4* sp = (const f32x4*)(SS + row * 32);
            f32x4 t = sp[0];
#pragma unroll
            for (int q = 1; q < 8; ++q) t += sp[q];
            const float rstd = rsqrtf(((t[0] + t[1]) + (t[2] + t[3])) * (1.0f / DM) + EPS);
            const f32x4 g = *(const LAS f32x4*)(red + m * PSTR + i4) * rstd, up = *(const LAS f32x4*)(red + m * PSTR + 32 + i4) * rstd;
            f32x4 a;
#pragma unroll
            for (int e = 0; e < 4; ++e) a[e] = g[e] * sigm(g[e]) * up[e];
            *(u32x2*)(ACT + row * DFF + j * 32 + i4) = pack4(a);
        }
    }
};
struct SkDown {
    float* H;
    __device__ __forceinline__ void run(const LAS float* red, int j, int tid) const {
        const int m = tid >> 4, c4 = (tid & 15) * 4; float* hp = H + (size_t)(MP + m) * DM + j * 64 + c4;
        *(f32x4*)hp = *(const f32x4*)hp + *(const LAS f32x4*)(red + m * PSTR + c4);
    }
};
}

namespace att {
typedef short v4i16_t __attribute__((ext_vector_type(4)));
typedef LAS const char* lds_cptr;
constexpr int LDS_K = 0, LDS_V = 16384, LDS_OST = 32768, LDS_BYTES = 65536;
__device__ __forceinline__ s16x4 vtr(lds_cptr p) { return __builtin_bit_cast(s16x4, __builtin_amdgcn_ds_read_tr16_b64_v4i16((LAS v4i16_t*)p)); }

template <int MODE>
__device__ __forceinline__ void sb_tile(f32x16 (&o)[2], float& carry, const bf16x8 (&qr)[4], lds_cptr kp, lds_cptr vp, float bias2, int qrel, int hi) {
    f32x16 p0, p1;
#pragma unroll
    for (int r = 0; r < 16; ++r) { p0[r] = bias2; p1[r] = bias2; }
#pragma unroll
    for (int d0 = 0; d0 < 4; ++d0) {
        const bf16x8 b0 = *(const LAS bf16x8*)(kp + d0 * 2048), b1 = *(const LAS bf16x8*)(kp + d0 * 2048 + 512);
        p0 = __builtin_amdgcn_mfma_f32_32x32x16_bf16(b0, qr[d0], p0, 0, 0, 0);
        p1 = __builtin_amdgcn_mfma_f32_32x32x16_bf16(b1, qr[d0], p1, 0, 0, 0);
    }
    if (MODE == 1) {
#pragma unroll
        for (int r = 0; r < 16; ++r) { const int kv = (r & 3) + 8 * (r >> 2) + 4 * hi; if (kv >= qrel) p0[r] = -INFINITY; if (kv + 32 >= qrel) p1[r] = -INFINITY; }
    }
    float e[32], s[32], G[8];
#pragma unroll
    for (int r = 0; r < 16; ++r) { e[r] = __builtin_amdgcn_exp2f(p0[r]); e[16 + r] = __builtin_amdgcn_exp2f(p1[r]); }
#pragma unroll
    for (int r = 0; r < 32; ++r) s[r] = __builtin_amdgcn_rcpf(1.0f + e[r]);
#pragma unroll
    for (int gi = 0; gi < 8; ++gi) { s[4 * gi + 2] *= s[4 * gi + 3]; s[4 * gi + 1] *= s[4 * gi + 2]; s[4 * gi] *= s[4 * gi + 1]; G[gi] = s[4 * gi]; }
    float S = carry;
#pragma unroll
    for (int gi = 7; gi >= 0; --gi) {
        const auto rr = __builtin_amdgcn_permlane32_swap(__float_as_uint(G[gi]), __float_as_uint(G[gi]), false, false);
        const float Glo = __uint_as_float(rr[0]), Ghi = __uint_as_float(rr[1]);
        const float E = hi ? S : S * Ghi;
#pragma unroll
        for (int j = 0; j < 4; ++j) e[4 * gi + j] = e[4 * gi + j] * s[4 * gi + j] * E;
        S = S * (Glo * Ghi);
    }
    carry = S;
    bf16x8 pa[4];
#pragma unroll
    for (int ks = 0; ks < 4; ++ks) { u32x4 w; w.x = cvtpk(e[8 * ks], e[8 * ks + 1]); w.y = cvtpk(e[8 * ks + 2], e[8 * ks + 3]); w.z = cvtpk(e[8 * ks + 4], e[8 * ks + 5]); w.w = cvtpk(e[8 * ks + 6], e[8 * ks + 7]);
        pa[ks] = __builtin_bit_cast(bf16x8, w); }
#pragma unroll
    for (int dh = 0; dh < 2; ++dh)
#pragma unroll
        for (int ks = 0; ks < 4; ++ks) {
            const s16x4 lo = vtr(vp + dh * 4096 + ks * 1024), hi4 = vtr(vp + dh * 4096 + ks * 1024 + 512);
            const bf16x8 vf = (bf16x8){lo[0], lo[1], lo[2], lo[3], hi4[0], hi4[1], hi4[2], hi4[3]};
            o[dh] = __builtin_amdgcn_mfma_f32_32x32x16_bf16(pa[ks], vf, o[dh], 0, 0, 0);
        }
}

__device__ __forceinline__ void prompt_unit(int b, int h, int qb, const bf16_t* Q, const bf16_t* K, const bf16_t* V, bf16_t* O, const float* sbb, LAS unsigned char* lds) {
    const int tid = threadIdx.x, lane = tid & 63, r32 = lane & 31, hi = lane >> 5; const int wid = __builtin_amdgcn_readfirstlane(tid >> 6);
    const size_t rowbase = (size_t)b * SEQ; const int q0 = qb * 256;
    const bf16_t* Qw = Q + (rowbase + q0 + wid * 32) * AW + h * HD;
    const bf16_t* Kh = K + rowbase * AW + h * HD; const bf16_t* Vh = V + rowbase * AW + h * HD;
    const bf16_t* ksrc = Kh + (size_t)lane * AW + wid * 8;
    const bf16_t* vsrc = Vh + (size_t)(16 * (wid & 3) + (lane >> 2)) * AW + (wid >> 2) * 32 + (lane & 3) * 8;
    const lds_cptr l3 = (lds_cptr)lds;
    const lds_cptr kp0 = l3 + LDS_K + hi * 1024 + r32 * 16;
    const lds_cptr vp0 = l3 + LDS_V + ((lane >> 4) & 1) * 32 + (lane & 3) * 8 + (4 * hi + ((lane & 15) >> 2)) * 64;
#define ATT_DMA(t, slot) do { \
        __builtin_amdgcn_global_load_lds((const unsigned*)(ksrc + (size_t)(t) * 64 * AW), (LAS unsigned*)(lds + LDS_K + (slot) * 8192 + wid * 1024), 16, 0, 0); \
        __builtin_amdgcn_global_load_lds((const unsigned*)(vsrc + (size_t)(t) * 64 * AW), (LAS unsigned*)(lds + LDS_V + (slot) * 8192 + wid * 1024), 16, 0, 0); } while (0)
    const int NT = (q0 + 256) / 64;
    ATT_DMA(NT - 1, 0);
    bf16x8 qr[4];
#pragma unroll
    for (int d0 = 0; d0 < 4; ++d0) qr[d0] = *(const bf16x8*)(Qw + (size_t)r32 * AW + d0 * 16 + hi * 8);
    const float bias2 = sbb[h] * LOG2E;
    f32x16 o[2]; o[0] = f32x16{}; o[1] = f32x16{};
    float carry = 1.0f;
    asm volatile("s_waitcnt vmcnt(0)" ::: "memory"); __builtin_amdgcn_s_barrier();
    int slot = 0;
    for (int t = NT - 1; t >= 0; --t) {
        if (t > 0) ATT_DMA(t - 1, slot ^ 1);
        const int qmin = q0 + wid * 32 - 64 * t;
        if (qmin + 31 > 0) {
            if (qmin >= 64) sb_tile<0>(o, carry, qr, kp0 + slot * 8192, vp0 + slot * 8192, bias2, 0, hi);
            else sb_tile<1>(o, carry, qr, kp0 + slot * 8192, vp0 + slot * 8192, bias2, qmin + r32, hi);
        }
        asm volatile("s_waitcnt vmcnt(0) lgkmcnt(0)" ::: "memory"); __builtin_amdgcn_s_barrier();
        slot ^= 1;
    }
#undef ATT_DMA
    LAS bf16_t* stg = (LAS bf16_t*)(lds + LDS_OST) + wid * 2048;
#pragma unroll
    for (int r = 0; r < 16; ++r) { const int orow = (r & 3) + 8 * (r >> 2) + 4 * hi;
#pragma unroll
        for (int dh = 0; dh < 2; ++dh) stg[orow * 64 + dh * 32 + r32] = (bf16_t)(cvtpk(o[dh][r], 0.f) & 0xffffu); }
    asm volatile("s_waitcnt lgkmcnt(0)" ::: "memory");
    bf16_t* Ow = O + (rowbase + q0 + wid * 32) * AW + h * HD;
#pragma unroll
    for (int i = 0; i < 4; ++i) { const int row = i * 8 + (lane >> 3), ch = lane & 7; const u32x4 v = *(const LAS u32x4*)(stg + row * 64 + ch * 8); *(u32x4*)(Ow + (size_t)row * AW + ch * 8) = v; }
    asm volatile("s_waitcnt lgkmcnt(0)" ::: "memory"); __builtin_amdgcn_s_barrier();
}

__device__ __forceinline__ void decode_unit(int b, int c, const bf16_t* Q, const float* ck, const float* cv, const int* pt, const float* sbb, float* DPO, float* DPW, LAS unsigned char* lds) {
    const int tid = threadIdx.x, lane = tid & 63, r32 = lane & 31, hi = lane >> 5; const int wid = __builtin_amdgcn_readfirstlane(tid >> 6);
    LAS unsigned char* wl = lds + wid * 16384;
    const lds_cptr kp0 = (lds_cptr)wl + hi * 1024 + r32 * 16;
    const lds_cptr vp0 = (lds_cptr)wl + 8192 + ((lane >> 4) & 1) * 32 + (lane & 3) * 8 + (4 * hi + ((lane & 15) >> 2)) * 64;
    const int tk = lane >> 4, d4 = (lane & 15) * 4;
    LAS unsigned char* kw = wl + (d4 >> 3) * 1024 + (d4 & 7) * 2;
    LAS unsigned char* vw = wl + 8192 + (d4 >> 5) * 4096 + (d4 & 31) * 2;
    for (int hh = 0; hh < 2; ++hh) {
        const int h = 2 * wid + hh;
        bf16x8 qr[4];
#pragma unroll
        for (int d0 = 0; d0 < 4; ++d0) { qr[d0] = (bf16x8){0, 0, 0, 0, 0, 0, 0, 0}; if (r32 < DS) qr[d0] = *(const bf16x8*)(Q + (size_t)(MP + b * DS + r32) * AW + h * HD + d0 * 16 + hi * 8); }
        const float bias2 = sbb[h] * LOG2E;
        f32x16 o[2]; o[0] = f32x16{}; o[1] = f32x16{};
        float carry = 1.0f;
        for (int tt = 7; tt >= 0; --tt) {
            const int page = pt[b * NPG + c * 4 + (tt >> 1)];
            const size_t tok0 = (size_t)page * PAGE + (tt & 1) * 64;
            const float* kb = ck + ((tok0 + tk) * NH + h) * HD + d4;
            const float* vb = cv + ((tok0 + tk) * NH + h) * HD + d4;
            f32x4 kr[16];
#pragma unroll
            for (int i = 0; i < 16; ++i) kr[i] = *(const f32x4*)(kb + (size_t)i * 4 * NH * HD);
#pragma unroll
            for (int i = 0; i < 16; ++i) { u32x2 w; w.x = cvtpk(kr[i][0], kr[i][1]); w.y = cvtpk(kr[i][2], kr[i][3]); *(LAS u32x2*)(kw + (4 * i + tk) * 16) = w; }
#pragma unroll
            for (int i = 0; i < 16; ++i) kr[i] = *(const f32x4*)(vb + (size_t)i * 4 * NH * HD);
#pragma unroll
            for (int i = 0; i < 16; ++i) { u32x2 w; w.x = cvtpk(kr[i][0], kr[i][1]); w.y = cvtpk(kr[i][2], kr[i][3]); *(LAS u32x2*)(vw + (4 * i + tk) * 64) = w; }
            asm volatile("s_waitcnt lgkmcnt(0)" ::: "memory");
            sb_tile<0>(o, carry, qr, kp0, vp0, bias2, 0, hi);
            asm volatile("s_waitcnt lgkmcnt(0)" ::: "memory");
        }
        if (hi == 0) {
            float* op = DPO + ((((size_t)b * NH + h) * DCH + c) * DS) * HD;
#pragma unroll
            for (int q = 0; q < DS; ++q)
#pragma unroll
                for (int dh = 0; dh < 2; ++dh) op[q * HD + dh * 32 + r32] = o[dh][q];
            if (r32 < DS) DPW[(((size_t)b * NH + h) * DCH + c) * DS + r32] = carry;
        }
    }
}
}

constexpr int NWAVES = 8;
constexpr int N_PHASES = 8;
constexpr size_t MiB = 1u << 20;
constexpr size_t WS_CTL = 0, CTL_ZERO_BYTES = 1 * MiB;
constexpr size_t WS_WIN = 2 * MiB, WS_WAP = 34 * MiB, WS_WPOOL = 38 * MiB, WS_WOUT = 40 * MiB, WS_WGU = 48 * MiB, WS_WD = 92 * MiB;
constexpr size_t WS_XN = 114 * MiB, WS_Q = 148 * MiB, WS_K = 165 * MiB, WS_V = 182 * MiB, WS_U = 199 * MiB, WS_SGA = 232 * MiB, WS_SGB = 265 * MiB;
constexpr size_t WS_P = 298 * MiB, WS_O = 315 * MiB, WS_MIX = 332 * MiB, WS_HB = 365 * MiB, WS_SS = 398 * MiB, WS_ACT = 400 * MiB, WS_DPO = 491 * MiB, WS_DPW = 495 * MiB, WS_END = 496 * MiB;
static_assert(WS_WIN + (size_t)INC * DM * 2 <= WS_WAP && WS_WAP + (size_t)DM * AW * 2 <= WS_WPOOL && WS_WPOOL + (size_t)DM * 256 * 2 <= WS_WOUT && WS_WOUT + (size_t)DM * DM * 2 <= WS_WGU &&
              WS_WGU + (size_t)2 * DFF * DM * 2 <= WS_WD && WS_WD + (size_t)DM * DFF * 2 <= WS_XN && WS_XN + (size_t)MPAD * DM * 2 <= WS_Q && WS_Q + (size_t)MPAD * AW * 2 <= WS_K &&
              WS_K + (size_t)MPAD * AW * 2 <= WS_V && WS_V + (size_t)MPAD * AW * 2 <= WS_U && WS_U + (size_t)MPAD * PW * 4 <= WS_SGA && WS_SGA + (size_t)MPAD * DM * 2 <= WS_SGB &&
              WS_SGB + (size_t)MPAD * DM * 2 <= WS_P && WS_P + (size_t)MPAD * PW * 2 <= WS_O && WS_O + (size_t)MPAD * AW * 2 <= WS_MIX && WS_MIX + (size_t)MPAD * DM * 2 <= WS_HB &&
              WS_HB + (size_t)MPAD * DM * 2 <= WS_SS && WS_SS + (size_t)MPAD * 32 * 4 <= WS_ACT && WS_ACT + (size_t)MPAD * DFF * 2 <= WS_DPO &&
              WS_DPO + (size_t)DB * NH * DCH * DS * HD * 4 <= WS_DPW && WS_DPW + (size_t)DB * NH * DCH * DS * 4 <= WS_END, "d_ws map");
constexpr int CW_TMO = 0, CW_BAR = 4096;
constexpr int RING_OFF = 0, RING_BYTES = 131072;
constexpr int LDSCTL_OFF = RING_BYTES, MISC_OFF = LDSCTL_OFF + 320;
constexpr int LDS_BYTES = 147456;

typedef GAS unsigned gu32;
#define RLX_AGENT __ATOMIC_RELAXED, __HIP_MEMORY_SCOPE_AGENT
#define LDS_WAIT() asm volatile("s_waitcnt lgkmcnt(0)" ::: "memory")

#define XB_TMO      128
#define XB_XCNT(j)  (256  + 64 * (j))
#define XB_XSUB(j)  (1280 + 64 * (j))
#define XB_XGEN(j)  (2304 + 64 * (j))
#define XB_TOP      3328
#define XB_TOPGEN   3392
#define XCD_BAR_WORDS 3456
#define XB_SPIN_CAP (1u << 18)
__device__ __forceinline__ unsigned xb_ld(unsigned* p)              { return __hip_atomic_load(p, __ATOMIC_RELAXED, __HIP_MEMORY_SCOPE_AGENT); }
__device__ __forceinline__ unsigned xb_add(unsigned* p, unsigned v) { return __hip_atomic_fetch_add(p, v, __ATOMIC_RELAXED, __HIP_MEMORY_SCOPE_AGENT); }
__device__ __forceinline__ unsigned xb_xcc_id() { return (unsigned)__builtin_amdgcn_s_getreg((3 << 11) | 20) & 0xFu; }
#define XB_SPIN(cond, bar) do { unsigned _sp = 0; while (cond) { __builtin_amdgcn_s_sleep(1); \
    if ((++_sp & 255u) == 0u) { if (xb_ld(&(bar)[XB_TMO])) break; if (_sp > XB_SPIN_CAP) { atomicAdd(&(bar)[XB_TMO], 1u); break; } } } } while (0)
struct XcdBarrier { unsigned* bar; unsigned x; volatile LAS unsigned* st; };
__device__ __forceinline__ XcdBarrier xcd_barrier_post(unsigned* bar, volatile LAS unsigned* st) {
    XcdBarrier b; b.bar = bar; b.x = xb_xcc_id(); b.st = st;
    if (threadIdx.x == 0) (void)xb_add(&bar[XB_XCNT(b.x)], 1u);
    return b;
}
__device__ __forceinline__ void xcd_barrier_complete(unsigned* bar, unsigned x, unsigned& nloc, unsigned& nx) {
    const unsigned G = gridDim.x * gridDim.y * gridDim.z;
    unsigned sum, cnt, mine, sp = 0u;
    for (;;) {
        sum = 0u; cnt = 0u; mine = 0u;
#pragma unroll
        for (unsigned j = 0; j < 16; ++j) { const unsigned c = xb_ld(&bar[XB_XCNT(j)]); sum += c; cnt += (c > 0u) ? 1u : 0u; mine = (j == x) ? c : mine; }
        if (sum == G) break;
        __builtin_amdgcn_s_sleep(1);
        if ((++sp & 255u) == 0u) { if (xb_ld(&bar[XB_TMO])) break; if (sp > XB_SPIN_CAP) { atomicAdd(&bar[XB_TMO], 1u); break; } }
    }
    nloc = mine > 0u ? mine : 1u; nx = cnt > 0u ? cnt : 1u;
}
__device__ __forceinline__ void xcd_barrier(const XcdBarrier& b) {
    asm volatile("s_waitcnt vmcnt(0)" ::: "memory");
    __syncthreads();
    if (threadIdx.x == 0) {
        unsigned* bar = b.bar;
        __builtin_amdgcn_s_waitcnt(0);
        unsigned nloc = b.st[0], nx = b.st[1];
        if (nloc == 0u) { xcd_barrier_complete(bar, b.x, nloc, nx); b.st[0] = nloc; b.st[1] = nx; }
        const unsigned old = xb_add(&bar[XB_XSUB(b.x)], 1u);
        const unsigned gen = old / nloc;
        if (old + 1u == (gen + 1u) * nloc) {
            __builtin_amdgcn_fence(__ATOMIC_RELEASE, "agent");
            asm volatile("s_waitcnt vmcnt(0)" ::: "memory");
            const unsigned og = xb_add(&bar[XB_TOP], 1u);
            const unsigned tg = og / nx;
            if (og + 1u == (tg + 1u) * nx) xb_add(&bar[XB_TOPGEN], 1u);
            else XB_SPIN(xb_ld(&bar[XB_TOPGEN]) == tg, bar);
            __builtin_amdgcn_fence(__ATOMIC_ACQUIRE, "agent");
            xb_add(&bar[XB_XGEN(b.x)], 1u);
            asm volatile("s_waitcnt vmcnt(0)" ::: "memory");
        } else {
            XB_SPIN(xb_ld(&bar[XB_XGEN(b.x)]) == gen, bar);
            __builtin_amdgcn_fence(__ATOMIC_ACQUIRE, "agent");
            asm volatile("s_waitcnt vmcnt(0)" ::: "memory");
        }
    }
    __syncthreads();
}

__device__ __forceinline__ float wave_sum(float v) {
#pragma unroll
    for (int o = 1; o < 64; o <<= 1) v += __shfl_xor(v, o);
    return v;
}

__device__ __forceinline__ void p0_transpose_item(const float* src, int ldn, bf16_t* dst, int ldk, const float* ksc, LAS float* scr, int lane) {
#pragma unroll 8
    for (int i = 0; i < 32; ++i) { const int kk = 2 * i + (lane >> 5); float v = src[(size_t)kk * ldn + (lane & 31)]; if (ksc) v *= ksc[kk]; scr[kk * 33 + (lane & 31)] = v; }
    LDS_WAIT(); asm volatile("" ::: "memory");
    const int c = lane & 7;
#pragma unroll
    for (int j = 0; j < 4; ++j) { const int n = (lane >> 3) + 8 * j; const LAS float* s = scr + (8 * c) * 33 + n;
        u32x4 o; o.x = cvtpk(s[0 * 33], s[1 * 33]); o.y = cvtpk(s[2 * 33], s[3 * 33]); o.z = cvtpk(s[4 * 33], s[5 * 33]); o.w = cvtpk(s[6 * 33], s[7 * 33]);
        *(u32x4*)(dst + (size_t)n * ldk + 8 * c) = o; }
    LDS_WAIT(); asm volatile("" ::: "memory");
}

struct Args { const void* in[18]; float* out; unsigned char* ws; int ph_lo, ph_hi, li, pad; };

__global__ void __launch_bounds__(NWAVES * 64, 2) fwd_kernel(Args args) {
    extern __shared__ __attribute__((aligned(16))) unsigned char lds_raw[];
    LAS unsigned char* lds = (LAS unsigned char*)lds_raw;
    volatile LAS unsigned* MISC = (volatile LAS unsigned*)(lds + MISC_OFF);
    const int tid = threadIdx.x, lane = tid & 63, wave = __builtin_amdgcn_readfirstlane(tid >> 6);
    const int G = gridDim.x; const int bx = blockIdx.x; const int vcu = (G % 8 == 0) ? (bx % 8) * (G / 8) + bx / 8 : bx;
    const int gw = vcu * NWAVES + wave, NGW = G * NWAVES;
    unsigned char* ws = args.ws;
    unsigned* ctl = (unsigned*)(ws + WS_CTL);
    const float* x_p = (const float*)args.in[0]; const float* x_s = (const float*)args.in[1];
    const float* cache_k = (const float*)args.in[2]; const float* cache_v = (const float*)args.in[3];
    const float* state_pool = (const float*)args.in[4]; const int* page_table = (const int*)args.in[5];
    const float* norm1_g = (const float*)args.in[6]; const float* w_in = (const float*)args.in[7];
    const float* q_g = (const float*)args.in[8]; const float* k_g = (const float*)args.in[9]; const float* sb_bias = (const float*)args.in[10];
    const float* w_ap = (const float*)args.in[11]; const float* w_pool = (const float*)args.in[12]; const float* pool_scale = (const float*)args.in[13];
    const float* w_out = (const float*)args.in[14]; const float* norm2_g = (const float*)args.in[15]; const float* w_gu = (const float*)args.in[16]; const float* w_down = (const float*)args.in[17];
    float* out = args.out;
    bf16_t* Win_t = (bf16_t*)(ws + WS_WIN); bf16_t* Wap_t = (bf16_t*)(ws + WS_WAP); bf16_t* Wpool_t = (bf16_t*)(ws + WS_WPOOL); bf16_t* Wout_t = (bf16_t*)(ws + WS_WOUT);
    bf16_t* Wgu_t = (bf16_t*)(ws + WS_WGU); bf16_t* Wd_t = (bf16_t*)(ws + WS_WD);
    bf16_t* XN = (bf16_t*)(ws + WS_XN); bf16_t* Qb = (bf16_t*)(ws + WS_Q); bf16_t* Kb = (bf16_t*)(ws + WS_K); bf16_t* Vb = (bf16_t*)(ws + WS_V);
    float* U = (float*)(ws + WS_U); bf16_t* SGA = (bf16_t*)(ws + WS_SGA); bf16_t* SGB = (bf16_t*)(ws + WS_SGB); bf16_t* Pb = (bf16_t*)(ws + WS_P); bf16_t* Ob = (bf16_t*)(ws + WS_O);
    bf16_t* MIX = (bf16_t*)(ws + WS_MIX); bf16_t* HB = (bf16_t*)(ws + WS_HB); float* SS = (float*)(ws + WS_SS); bf16_t* ACT = (bf16_t*)(ws + WS_ACT);
    float* DPO = (float*)(ws + WS_DPO); float* DPW = (float*)(ws + WS_DPW);

    for (int u = tid; u < (LDS_BYTES - LDSCTL_OFF) / 4; u += NWAVES * 64) ((LAS unsigned*)(lds + LDSCTL_OFF))[u] = 0u;
    __syncthreads();
    XcdBarrier bar; bar.bar = ctl + CW_BAR + args.li * XCD_BAR_WORDS; bar.x = 0; bar.st = nullptr;
    if (MK_N_LAUNCHES != N_PHASES) bar = xcd_barrier_post(ctl + CW_BAR + args.li * XCD_BAR_WORDS, MISC + 8);
    const int lo = args.ph_lo, hi_ph = args.ph_hi;
#define IN(k) (lo <= (k) && (k) < hi_ph)
#define BOTH(k) (IN(k) && IN((k) + 1))
#define GRID_BAR() do { if (MK_N_LAUNCHES != N_PHASES) xcd_barrier(bar); } while (0)

    if (IN(0)) {
        LAS float* scr = (LAS float*)(lds + RING_OFF + wave * 16384);
        constexpr int I_IN = (DM / 64) * (INC / 32), I_AP = (AW / 64) * (DM / 32), I_PL = 4 * (256 / 64) * (512 / 32), I_OUT = (DM / 64) * (DM / 32), I_GU = (DM / 64) * (2 * DFF / 32), I_DN = (DFF / 64) * (DM / 32);
        constexpr int NITEMS = I_IN + I_AP + I_PL + I_OUT + I_GU + I_DN;
        for (int it = gw; it < NITEMS; it += NGW) {
            int r = it;
            if (r < I_IN) { const int nblk = INC / 32, kb = r / nblk, nb = r % nblk, P0 = 32 * nb, pn = P0 >> 8, bj = (P0 >> 7) & 1, wc = (P0 >> 5) & 3, n0 = 256 * pn + 64 * wc + 32 * bj;
                p0_transpose_item(w_in + (size_t)(64 * kb) * INC + n0, INC, Win_t + (size_t)P0 * DM + 64 * kb, DM, nullptr, scr, lane); continue; } r -= I_IN;
            if (r < I_AP) { const int nblk = DM / 32, kb = r / nblk, nb = r % nblk;
                p0_transpose_item(w_ap + (size_t)(64 * kb) * DM + 32 * nb, DM, Wap_t + (size_t)(32 * nb) * AW + 64 * kb, AW, nullptr, scr, lane); continue; } r -= I_AP;
            if (r < I_PL) { const int gp = r / 64, r2 = r % 64, kb = r2 / 16, nb = r2 % 16;
                p0_transpose_item(w_pool + (size_t)gp * 256 * 512 + (size_t)(64 * kb) * 512 + 32 * nb, 512, Wpool_t + (size_t)(512 * gp + 32 * nb) * 256 + 64 * kb, 256, nullptr, scr, lane); continue; } r -= I_PL;
            if (r < I_OUT) { const int nblk = DM / 32, kb = r / nblk, nb = r % nblk;
                p0_transpose_item(w_out + (size_t)(64 * kb) * DM + 32 * nb, DM, Wout_t + (size_t)(32 * nb) * DM + 64 * kb, DM, nullptr, scr, lane); continue; } r -= I_OUT;
            if (r < I_GU) { const int nblk = 2 * DFF / 32, kb = r / nblk, nb = r % nblk, P0 = 32 * nb, pn = P0 >> 8, bj = (P0 >> 7) & 1, i0 = P0 & 127, n0 = bj * DFF + 128 * pn + i0;
                p0_transpose_item(w_gu + (size_t)(64 * kb) * (2 * DFF) + n0, 2 * DFF, Wgu_t + (size_t)P0 * DM + 64 * kb, DM, norm2_g + 64 * kb, scr, lane); continue; } r -= I_GU;
            { const int nblk = DM / 32, kb = r / nblk, nb = r % nblk;
                p0_transpose_item(w_down + (size_t)(64 * kb) * DM + 32 * nb, DM, Wd_t + (size_t)(32 * nb) * DFF + 64 * kb, DFF, nullptr, scr, lane); }
        }
        for (int mrow = gw; mrow < MR; mrow += NGW) {
            unsigned long long* o8 = (unsigned long long*)(XN + (size_t)mrow * DM) + lane;
            if (mrow < MR) {
                const float* xrow = mrow < MP ? x_p + (size_t)mrow * DM : x_s + (size_t)(mrow - MP) * DM;
                const f32x4* xr = (const f32x4*)xrow + lane;
                f32x4 v[8]; float s = 0.f;
#pragma unroll
                for (int j = 0; j < 8; ++j) { v[j] = xr[64 * j]; s += (v[j][0] * v[j][0] + v[j][1] * v[j][1]) + (v[j][2] * v[j][2] + v[j][3] * v[j][3]); }
                const float rstd = rsqrtf(wave_sum(s) * (1.0f / DM) + EPS);
#pragma unroll
                for (int j = 0; j < 8; ++j) { const f32x4 gg = *((const f32x4*)norm1_g + lane + 64 * j); const f32x4 y = v[j] * rstd * gg;
                    o8[64 * j] = (unsigned long long)cvtpk(y[0], y[1]) | ((unsigned long long)cvtpk(y[2], y[3]) << 32); }
            } else {
#pragma unroll
                for (int j = 0; j < 8; ++j) o8[64 * j] = 0ull;
            }
        }
        if (BOTH(0)) GRID_BAR();
    }

    if (IN(1)) {
        pg8::Gemm g{XN, Win_t, DM, DM, DM, 0, 0}; pg8::StaticOrder S; S.init(MP, INC, G, bx);
        pg8::EpiIn E{Qb, Kb, Vb, SGA, SGB, U, out, q_g, k_g};
        pg8::gemm_phase<pg8::EpiIn, pg8::StaticOrder>(lds + RING_OFF, g, S, E);
        { sk::SkIn SE{Qb, Kb, Vb, SGA, SGB, U, out, q_g, k_g};
          for (int j = G - 1 - bx; j < INC / 64; j += G) { const bf16_t* Bp = Win_t + (size_t)(256 * (j >> 2) + 32 * (j & 3)) * DM;
              sk::unit(lds + RING_OFF, XN + (size_t)MP * DM, DM, Bp, Bp + (size_t)128 * DM, DM, DM, SE, j); } }
        if (BOTH(1)) GRID_BAR();
    }

    if (IN(2)) {
        for (int it = gw; it < (MP / 32) * 4; it += NGW) {
            const int rb = it >> 2, gp = it & 3, w = 2 << gp, row0 = rb * 32, pos0 = row0 & (SEQ - 1), c = 256 * gp + 4 * lane;
            const float* up = U + (size_t)row0 * PW + c;
            f32x4 s = (f32x4){0.f, 0.f, 0.f, 0.f};
            for (int j = 1; j < w; ++j) if (pos0 - j >= 0) s += *(const f32x4*)(up - (long)j * PW);
            for (int i = 0; i < 32; ++i) {
                const int pos = pos0 + i;
                const f32x4 ut = *(const f32x4*)(up + (size_t)i * PW);
                s += ut;
                const float cnt = (float)(pos + 1 < w ? pos + 1 : w);
                const f32x4 p = s / cnt - ut;
                *(u32x2*)(Pb + (size_t)(row0 + i) * PW + c) = (u32x2){cvtpk(p[0], p[1]), cvtpk(p[2], p[3])};
                if (pos - (w - 1) >= 0) s -= *(const f32x4*)(up + (long)(i - (w - 1)) * PW);
                if (pos >= SEQ - PSTATE) *(f32x4*)(out + OFF_PP + ((size_t)(row0 / SEQ) * PSTATE + (pos - (SEQ - PSTATE))) * PW + c) = ut;
            }
        }
        for (int it = gw; it < DB * 4; it += NGW) {
            const int b = it >> 2, gp = it & 3, w = 2 << gp, c = 256 * gp + 4 * lane;
            const float* st = state_pool + (size_t)b * PSTATE * PW + c; const float* un = U + (size_t)(MP + b * DS) * PW + c;
            for (int i = 0; i < DS; ++i) {
                f32x4 s = (f32x4){0.f, 0.f, 0.f, 0.f};
                for (int j = 0; j < w; ++j) { const int e = PSTATE + i - j; s += e >= PSTATE ? *(const f32x4*)(un + (size_t)(e - PSTATE) * PW) : *(const f32x4*)(st + (size_t)e * PW); }
                const f32x4 ut = *(const f32x4*)(un + (size_t)i * PW);
                const f32x4 p = s / (float)w - ut;
                *(u32x2*)(Pb + (size_t)(MP + b * DS + i) * PW + c) = (u32x2){cvtpk(p[0], p[1]), cvtpk(p[2], p[3])};
            }
            for (int j = 0; j < PSTATE; ++j) { const int e = DS + j;
                *(f32x4*)(out + OFF_PS + ((size_t)b * PSTATE + j) * PW + c) = e >= PSTATE ? *(const f32x4*)(un + (size_t)(e - PSTATE) * PW) : *(const f32x4*)(st + (size_t)e * PW); }
        }
        __syncthreads();
        for (int half = 0; half < 2; ++half) {
            if ((half == 0) == ((vcu & 1) == 0)) {
                for (int id = vcu; id < DB * DCH; id += G) att::decode_unit(id / DCH, id % DCH, Qb, cache_k, cache_v, page_table, sb_bias, DPO, DPW, lds + RING_OFF);
            } else {
                for (int pi = vcu; pi < NB * NH * 8; pi += G) { const int bh = pi >> 3, s = pi & 7;
                    att::prompt_unit(bh / NH, bh % NH, s, Qb, Kb, Vb, Ob, sb_bias, lds + RING_OFF);
                    att::prompt_unit(bh / NH, bh % NH, 15 - s, Qb, Kb, Vb, Ob, sb_bias, lds + RING_OFF); }
            }
            __syncthreads();
        }
        if (BOTH(2)) GRID_BAR();
    }

    if (IN(3)) {
        for (int id = gw; id < DB * NH * DS; id += NGW) {
            const int b = id / (NH * DS), h = (id / DS) % NH, i = id % DS;
            const size_t r0 = (size_t)(MP + b * DS);
            const float qd = bflo((unsigned)Qb[(r0 + i) * AW + h * HD + lane]);
            const float bias2 = sb_bias[h] * LOG2E;
            float carry = 1.0f, o = 0.f;
            for (int j = i - 1; j >= 0; --j) {
                const float kd = bflo((unsigned)Kb[(r0 + j) * AW + h * HD + lane]), vd = bflo((unsigned)Vb[(r0 + j) * AW + h * HD + lane]);
                const float z2 = wave_sum(qd * kd) + bias2;
                const float e = __builtin_amdgcn_exp2f(z2), w = __builtin_amdgcn_rcpf(1.0f + e);
                carry *= w; o += e * carry * vd;
            }
            const float* op = DPO + (((size_t)b * NH + h) * DCH * DS + i) * HD + lane; const float* wp = DPW + ((size_t)b * NH + h) * DCH * DS + i;
            for (int c = DCH - 1; c >= 0; --c) { o += carry * op[(size_t)c * DS * HD]; carry *= wp[c * DS]; }
            Ob[(r0 + i) * AW + h * HD + lane] = (bf16_t)(cvtpk(o, 0.f) & 0xffffu);
        }
        if (BOTH(3)) GRID_BAR();
    }

    if (IN(4)) {
        pg8::StaticOrder S; S.init(MP, DM, G, bx);
        { pg8::Gemm g{Pb, Wpool_t, PW, 256, 256, 1, 256}; pg8::EpiPool E{SGB, pool_scale, MIX};
          pg8::gemm_phase<pg8::EpiPool, pg8::StaticOrder>(lds + RING_OFF, g, S, E); }
        { pg8::Gemm g{Ob, Wap_t, AW, AW, AW, 0, 0}; pg8::EpiProj E{SGA, MIX};
          pg8::gemm_phase<pg8::EpiProj, pg8::StaticOrder>(lds + RING_OFF, g, S, E); }
        { sk::SkPool SE1{SGB, pool_scale, MIX}; sk::SkProj SE2{SGA, MIX};
          for (int j = G - 1 - bx; j < DM / 64; j += G) {
              { const bf16_t* Bp = Wpool_t + (size_t)(64 * j) * 256; sk::unit(lds + RING_OFF, Pb + (size_t)MP * PW + (j >> 3) * 256, PW, Bp, Bp + (size_t)32 * 256, 256, 256, SE1, j); }
              __syncthreads();
              { const bf16_t* Bp = Wap_t + (size_t)(64 * j) * AW; sk::unit(lds + RING_OFF, Ob + (size_t)MP * AW, AW, Bp, Bp + (size_t)32 * AW, AW, AW, SE2, j); }
              __syncthreads(); } }
        if (BOTH(4)) GRID_BAR();
    }

    if (IN(5)) {
        pg8::Gemm g{MIX, Wout_t, DM, DM, DM, 0, 0}; pg8::StaticOrder S; S.init(MP, DM, G, bx);
        pg8::EpiOut E{x_p, x_s, out, HB, SS};
        pg8::gemm_phase<pg8::EpiOut, pg8::StaticOrder>(lds + RING_OFF, g, S, E);
        { sk::SkOut SE{x_s, out, HB, SS};
          for (int j = G - 1 - bx; j < DM / 64; j += G) { const bf16_t* Bp = Wout_t + (size_t)(64 * j) * DM;
              sk::unit(lds + RING_OFF, MIX + (size_t)MP * DM, DM, Bp, Bp + (size_t)32 * DM, DM, DM, SE, j); __syncthreads(); } }
        if (BOTH(5)) GRID_BAR();
    }

    if (IN(6)) {
        pg8::Gemm g{HB, Wgu_t, DM, DM, DM, 0, 0}; pg8::StaticOrder S; S.init(MP, 2 * DFF, G, bx);
        pg8::EpiGU E{SS, ACT};
        pg8::gemm_phase<pg8::EpiGU, pg8::StaticOrder>(lds + RING_OFF, g, S, E);
        { sk::SkGU SE{SS, ACT};
          for (int j = G - 1 - bx; j < DFF / 32; j += G) { const bf16_t* Bp = Wgu_t + (size_t)(256 * (j >> 2) + 32 * (j & 3)) * DM;
              sk::unit(lds + RING_OFF, HB + (size_t)MP * DM, DM, Bp, Bp + (size_t)128 * DM, DM, DM, SE, j); __syncthreads(); } }
        if (BOTH(6)) GRID_BAR();
    }

    if (IN(7)) {
        pg8::Gemm g{ACT, Wd_t, DFF, DFF, DFF, 0, 0}; pg8::StaticOrder S; S.init(MP, DM, G, bx);
        pg8::EpiDown E{out};
        pg8::gemm_phase<pg8::EpiDown, pg8::StaticOrder>(lds + RING_OFF, g, S, E);
        { sk::SkDown SE{out};
          for (int j = G - 1 - bx; j < DM / 64; j += G) { const bf16_t* Bp = Wd_t + (size_t)(64 * j) * DFF;
              sk::unit(lds + RING_OFF, ACT + (size_t)MP * DFF, DFF, Bp, Bp + (size_t)32 * DFF, DFF, DFF, SE, j); __syncthreads(); } }
    }
#undef IN
#undef BOTH
#undef GRID_BAR
}

extern "C" void kernel_launch(void* const* d_in, const int* in_sizes, int n_in, void* d_out, int out_size, void* d_ws, size_t ws_size, hipStream_t stream) {
    static int grid = 0;
    if (grid == 0) {
        if (n_in != 18 || (size_t)out_size != OUT_TOTAL || ws_size < WS_END) { fprintf(stderr, "kernel_launch: unexpected sizes (n_in %d, out %d, ws %zu)\n", n_in, out_size, ws_size); grid = -1; return; }
        int dev = 0, cus = 0, per_cu = 0;
        if (hipGetDevice(&dev) != hipSuccess || hipDeviceGetAttribute(&cus, hipDeviceAttributeMultiprocessorCount, dev) != hipSuccess) { grid = -1; return; }
        if (hipFuncSetAttribute((const void*)fwd_kernel, hipFuncAttributeMaxDynamicSharedMemorySize, LDS_BYTES) != hipSuccess) { fprintf(stderr, "kernel_launch: hipFuncSetAttribute failed\n"); grid = -1; return; }
        if (hipOccupancyMaxActiveBlocksPerMultiprocessor(&per_cu, (const void*)fwd_kernel, NWAVES * 64, LDS_BYTES) != hipSuccess || per_cu < 1)
            fprintf(stderr, "kernel_launch: occupancy query reports %d workgroups per CU\n", per_cu);
        (void)hipGetLastError();
        grid = cus;
    }
    if (grid < 0) return;
    if (hipMemsetAsync((char*)d_ws + WS_CTL, 0, CTL_ZERO_BYTES, stream) != hipSuccess) return;
    Args a{};
    for (int i = 0; i < 18; ++i) a.in[i] = d_in[i];
    a.out = (float*)d_out; a.ws = (unsigned char*)d_ws;
    if (PROBE_PH >= 0) {
        a.ph_lo = 0; a.ph_hi = PROBE_PH + 1; a.li = 0; hipLaunchKernelGGL(fwd_kernel, dim3(grid), dim3(NWAVES * 64), LDS_BYTES, stream, a);
        a.ph_lo = PROBE_PH; a.ph_hi = N_PHASES; a.li = 1; hipLaunchKernelGGL(fwd_kernel, dim3(grid), dim3(NWAVES * 64), LDS_BYTES, stream, a);
    } else if (MK_N_LAUNCHES == N_PHASES) {
        for (int li = 0; li < N_PHASES; ++li) { a.ph_lo = li; a.ph_hi = li + 1; a.li = 0; hipLaunchKernelGGL(fwd_kernel, dim3(grid), dim3(NWAVES * 64), LDS_BYTES, stream, a); }
    } else {
        a.ph_lo = 0; a.ph_hi = N_PHASES; a.li = 0;
        hipLaunchKernelGGL(fwd_kernel, dim3(grid), dim3(NWAVES * 64), LDS_BYTES, stream, a);
    }
}
```

```cpp
#include <hip/hip_runtime.h>
#include <cstdio>
#include <cstdint>

#define LAS __attribute__((address_space(3)))
#define GAS __attribute__((address_space(1)))
typedef unsigned short bf16_t;
typedef short bf16x8 __attribute__((ext_vector_type(8)));
typedef short s16x4 __attribute__((ext_vector_type(4)));
typedef float f32x2 __attribute__((ext_vector_type(2)));
typedef float f32x4 __attribute__((ext_vector_type(4)));
typedef float f32x16 __attribute__((ext_vector_type(16)));
typedef unsigned u32x2 __attribute__((ext_vector_type(2)));
typedef unsigned u32x4 __attribute__((ext_vector_type(4)));
typedef __bf16 bf16x2_t __attribute__((ext_vector_type(2)));

#ifndef MK_N_LAUNCHES
#define MK_N_LAUNCHES 1
#endif
#ifndef PROBE_T
#define PROBE_T -1
#endif
#ifndef PROBE_BLK
#define PROBE_BLK 0
#endif
#ifndef PROBE_PH
#define PROBE_PH -1
#endif

constexpr int DM = 2048, NB = 2, SEQ = 4096, MP = NB * SEQ, DB = 8, DS = 4, MS = DB * DS, MR = MP + MS, MPAD = 8448;
constexpr int NH = 16, HD = 64, AW = 1024, PW = 1024, DFF = 5632, INC = 8192;
constexpr int PAST = 16384, PAGE = 128, NPG = PAST / PAGE, PSTATE = 15;
constexpr int DCH = 32;
constexpr float LOG2E = 1.4426950408889634f, C2 = 0.125f * LOG2E, EPS = 1e-6f;
constexpr size_t OFF_YP = 0, OFF_YS = (size_t)MP * DM, OFF_KP = OFF_YS + (size_t)MS * DM, OFF_VP = OFF_KP + (size_t)MP * AW, OFF_PP = OFF_VP + (size_t)MP * AW,
                 OFF_KS = OFF_PP + (size_t)NB * PSTATE * PW, OFF_VS = OFF_KS + (size_t)MS * AW, OFF_PS = OFF_VS + (size_t)MS * AW, OUT_TOTAL = OFF_PS + (size_t)DB * PSTATE * PW;

__device__ __forceinline__ unsigned cvtpk(float lo, float hi) { f32x2 v = {lo, hi}; bf16x2_t b = __builtin_convertvector(v, bf16x2_t); return __builtin_bit_cast(unsigned, b); }
__device__ __forceinline__ float bflo(unsigned u) { return __uint_as_float(u << 16); }
__device__ __forceinline__ float bfhi(unsigned u) { return __uint_as_float(u & 0xffff0000u); }
__device__ __forceinline__ u32x4 pack8(const f32x4 a, const f32x4 b) { u32x4 w; w.x = cvtpk(a[0], a[1]); w.y = cvtpk(a[2], a[3]); w.z = cvtpk(b[0], b[1]); w.w = cvtpk(b[2], b[3]); return w; }
__device__ __forceinline__ void unpack8(const u32x4 w, f32x4& a, f32x4& b) { a = (f32x4){bflo(w.x), bfhi(w.x), bflo(w.y), bfhi(w.y)}; b = (f32x4){bflo(w.z), bfhi(w.z), bflo(w.w), bfhi(w.w)}; }
__device__ __forceinline__ float sigm(float x) { return 1.0f / (1.0f + __expf(-x)); }

namespace pg8 {
constexpr int BM = 256, BK = 64, HALF = 128, HTB = HALF * BK * 2  , STAGE_BYTES = 8 * HTB, NXCD = 8, WGM = 8;
__host__ __device__ __forceinline__ int lds_byte(int r, int c) { const int st = (r >> 4) * 2 + (c >> 5), rr = r & 15, cc = c & 31, ob = rr * 64 + cc * 2; return st * 1024 + (ob ^ (((ob >> 9) & 1) << 5)); }
__host__ __device__ __forceinline__ void stage_rc(int b, int& R, int& C) { const int st = b / 1024, sb = b % 1024, swz = sb ^ (((sb >> 9) & 1) << 5); R = (st >> 1) * 16 + swz / 64; C = (st & 1) * 32 + (swz % 64) / 2; }
__host__ __device__ __forceinline__ int perm32(int rho) { const int n = rho >> 4, i = rho & 15; return 8 * (i >> 2) + 4 * n + (i & 3); }

struct Unit { int pm, pn; };
struct Gemm { const bf16_t* A; const bf16_t* Bt; int lda, ldb, K, agrp_shift, agrp_stride; };

struct StaticOrder {
    int nM, nN, nwg, G, c;
    __host__ __device__ void init(int M, int N, int G_, int c_) { nM = M / BM; nN = N / BM; nwg = nM * nN; G = G_; c = c_; }
    __host__ __device__ bool next(int i, Unit& u) const {
        const long L = (long)i * G + c; if (L >= nwg) return false;
        int wgid = (int)L; { const int q = nwg / NXCD, r = nwg % NXCD, xcd = wgid % NXCD, off = wgid / NXCD; wgid = (xcd < r ? xcd * (q + 1) : r * (q + 1) + (xcd - r) * q) + off; }
        const int nig = WGM * nN, gid = wgid / nig, fm = gid * WGM, gsz = (nM - fm) < WGM ? (nM - fm) : WGM;
        u.pm = fm + ((wgid % nig) % gsz); u.pn = (wgid % nig) / gsz; return true;
    }
    __device__ __forceinline__ void a_ready(const Unit&) const {}
    __device__ __forceinline__ void done(const Unit&) const {}
};

template <class Epi, class Sched>
__device__ __forceinline__ void gemm_phase(LAS unsigned char* lds, const Gemm g, const Sched& S, const Epi& E) {
    const int tid = threadIdx.x, wid = __builtin_amdgcn_readfirstlane(tid >> 6), lane = tid & 63, wr = wid >> 2, wc = wid & 3, fr = lane & 15, fq = lane >> 4;
    int nt = g.K / BK; asm volatile("" : "+s"(nt));
    unsigned voffA[2], voffB[2];
#pragma unroll
    for (int i = 0; i < 2; ++i) { int R, C; stage_rc(tid * 16 + i * 8192, R, C); const int Rb = Epi::PERM ? ((R & ~31) + perm32(R & 31)) : R;
        voffA[i] = (unsigned)(R * g.lda + C) * 2u; voffB[i] = (unsigned)(Rb * g.ldb + C) * 2u; }
    const size_t kstep = (size_t)(BK * 2);
    const size_t hstepA = (size_t)HALF * g.lda * 2, hstepB = (size_t)HALF * g.ldb * 2;
    const size_t tstepA = 2 * hstepA, tstepB = 2 * hstepB;
    const unsigned ldsw = (unsigned)wid * 1024u;
    const int aoff = lds_byte(wr * 64 + fr, fq * 8), boff = lds_byte(wc * 32 + fr, fq * 8);
#define PG8_SA(b, h) (((b) * 2 + (h)) * HTB)
#define PG8_SB(b, h) ((4 + (b) * 2 + (h)) * HTB)
#define PG8_STAGE(bufoff, gbase, voff) do { _Pragma("unroll") for (int _i = 0; _i < 2; ++_i) \
        __builtin_amdgcn_global_load_lds((const unsigned*)((const char*)(gbase) + (voff)[_i]), (LAS unsigned*)(lds + (bufoff) + ldsw + _i * 8192), 16, 0, 0); } while (0)
#define PG8_LDA(dst, b, h) do { _Pragma("unroll") for (int m = 0; m < 4; ++m) _Pragma("unroll") for (int k = 0; k < 2; ++k) dst[m][k] = *(const LAS bf16x8*)(lds + PG8_SA(b, h) + aoff + m * 2048 + k * 1024); } while (0)
#define PG8_LDB(dst, b, h) do { _Pragma("unroll") for (int n = 0; n < 2; ++n) _Pragma("unroll") for (int k = 0; k < 2; ++k) dst[n][k] = *(const LAS bf16x8*)(lds + PG8_SB(b, h) + boff + n * 2048 + k * 1024); } while (0)
#define PG8_MMA(ai, bj, At, Bt) do { __builtin_amdgcn_s_setprio(1); _Pragma("unroll") for (int m = 0; m < 4; ++m) _Pragma("unroll") for (int n = 0; n < 2; ++n) _Pragma("unroll") for (int k = 0; k < 2; ++k) \
        acc[ai][bj][m][n] = __builtin_amdgcn_mfma_f32_16x16x32_bf16(Bt[n][k], At[m][k], acc[ai][bj][m][n], 0, 0, 0); __builtin_amdgcn_s_setprio(0); } while (0)
#define PG8_WAIT_V(n) asm volatile("s_waitcnt vmcnt(" #n ")" ::: "memory")
#define PG8_WAIT_L(n) asm volatile("s_waitcnt lgkmcnt(" #n ")" ::: "memory")
#define PG8_BAR __builtin_amdgcn_s_barrier()
#define PG8_SCHED __builtin_amdgcn_sched_barrier(0)
#define PG8_ABASE(u) ((const char*)g.A + (size_t)(u).pm * tstepA + (size_t)(((u).pn >> g.agrp_shift) * g.agrp_stride) * 2)
    Unit cur, nxt; int ui = 0;
    if (!S.next(0, cur)) return;
    f32x4 acc[2][2][4][2];
#pragma unroll
    for (int a = 0; a < 2; ++a)
#pragma unroll
        for (int b = 0; b < 2; ++b)
#pragma unroll
            for (int m = 0; m < 4; ++m)
#pragma unroll
                for (int n = 0; n < 2; ++n) acc[a][b][m][n] = (f32x4){0.f, 0.f, 0.f, 0.f};
    bf16x8 At[4][2], B0[2][2], B1[2][2];
    const char* cA = PG8_ABASE(cur); const char* cB = (const char*)g.Bt + (size_t)cur.pn * tstepB;
    S.a_ready(cur);
    PG8_STAGE(PG8_SB(0, 0), cB, voffB); PG8_STAGE(PG8_SB(0, 1), cB + hstepB, voffB); PG8_STAGE(PG8_SA(0, 0), cA, voffA); PG8_STAGE(PG8_SA(0, 1), cA + hstepA, voffA);
    if (wr == 1) PG8_BAR;
    PG8_WAIT_V(2); PG8_BAR;
    PG8_STAGE(PG8_SB(1, 0), cB + kstep, voffB); PG8_STAGE(PG8_SA(1, 0), cA + kstep, voffA); PG8_STAGE(PG8_SB(1, 1), cB + hstepB + kstep, voffB);
    PG8_WAIT_V(6); PG8_BAR;
    for (;;) {
        const bool has_next = S.next(ui + 1, nxt);
        const char* nA = has_next ? PG8_ABASE(nxt) : cA; const char* nB = has_next ? (const char*)g.Bt + (size_t)nxt.pn * tstepB : cB;
        for (int t = 0; t < nt; t += 2) {
            const bool last = (t == nt - 2);
            const char* a1 = cA + (size_t)(t + 1) * kstep;
            const char* a2 = last ? nA : cA + (size_t)(t + 2) * kstep; const char* b2 = last ? nB : cB + (size_t)(t + 2) * kstep;
            const char* a3 = a2 + kstep; const char* b3 = b2 + kstep;
            if (last && has_next) S.a_ready(nxt);
            PG8_LDB(B0, 0, 0); PG8_LDB(B1, 0, 1); PG8_SCHED; PG8_LDA(At, 0, 0); PG8_STAGE(PG8_SA(1, 1), a1 + hstepA, voffA);
            PG8_WAIT_V(8); PG8_WAIT_L(0); PG8_BAR; PG8_MMA(0, 0, At, B0); PG8_MMA(0, 1, At, B1); PG8_BAR; PG8_SCHED;
            PG8_LDA(At, 0, 1); PG8_STAGE(PG8_SB(0, 0), b2, voffB); PG8_STAGE(PG8_SB(0, 1), b2 + hstepB, voffB); PG8_STAGE(PG8_SA(0, 0), a2, voffA);
            PG8_WAIT_V(8); PG8_WAIT_L(0); PG8_BAR; PG8_MMA(1, 0, At, B0); PG8_MMA(1, 1, At, B1); PG8_BAR; PG8_SCHED;
            PG8_LDB(B0, 1, 0); PG8_LDB(B1, 1, 1); PG8_SCHED; PG8_LDA(At, 1, 0); PG8_STAGE(PG8_SA(0, 1), a2 + hstepA, voffA);
            PG8_WAIT_V(8); PG8_WAIT_L(0); PG8_BAR; PG8_MMA(0, 0, At, B0); PG8_MMA(0, 1, At, B1); PG8_BAR; PG8_SCHED;
            PG8_LDA(At, 1, 1); PG8_STAGE(PG8_SB(1, 0), b3, voffB); PG8_STAGE(PG8_SB(1, 1), b3 + hstepB, voffB); PG8_STAGE(PG8_SA(1, 0), a3, voffA);
            PG8_WAIT_V(8); PG8_WAIT_L(0); PG8_BAR; PG8_MMA(1, 0, At, B0); PG8_MMA(1, 1, At, B1); PG8_BAR; PG8_SCHED;
        }
        if (wr == 0) PG8_BAR;
        E(acc, cur, wr, wc, fr, fq); S.done(cur);
        if (!has_next) break;
#pragma unroll
        for (int a = 0; a < 2; ++a)
#pragma unroll
            for (int b = 0; b < 2; ++b)
#pragma unroll
                for (int m = 0; m < 4; ++m)
#pragma unroll
                    for (int n = 0; n < 2; ++n) acc[a][b][m][n] = (f32x4){0.f, 0.f, 0.f, 0.f};
        cur = nxt; cA = nA; cB = nB; ++ui;
        if (wr == 1) PG8_BAR;
    }
    PG8_WAIT_V(0);
    PG8_BAR;
#undef PG8_SA
#undef PG8_SB
#undef PG8_STAGE
#undef PG8_LDA
#undef PG8_LDB
#undef PG8_MMA
#undef PG8_WAIT_V
#undef PG8_WAIT_L
#undef PG8_BAR
#undef PG8_SCHED
#undef PG8_ABASE
}

#define EPI_ROWS_BEGIN _Pragma("unroll") for (int ai = 0; ai < 2; ++ai) _Pragma("unroll") for (int m = 0; m < 4; ++m) { \
        const int row0 = u.pm * BM + ai * HALF + wr * 64 + m * 16; if (row0 < MR) { const int row = row0 + fr;
#define EPI_ROWS_END } }

struct EpiIn {
    static constexpr bool PERM = true;
    bf16_t *Q, *Kb, *Vb, *SGA, *SGB; float* U; float* out; const float *qg, *kg;
    __device__ __forceinline__ void operator()(const f32x4 (&acc)[2][2][4][2], const Unit& u, int wr, int wc, int fr, int fq) const {
        const int kind = u.pn >> 2;
        EPI_ROWS_BEGIN
            if (kind <= 1) {
                float ss = 0.f;
#pragma unroll
                for (int bj = 0; bj < 2; ++bj)
#pragma unroll
                    for (int n = 0; n < 2; ++n) { const f32x4 x = acc[ai][bj][m][n]; ss += (x[0] * x[0] + x[1] * x[1]) + (x[2] * x[2] + x[3] * x[3]); }
                ss += __shfl_xor(ss, 16); ss += __shfl_xor(ss, 32);
                const float sc = rsqrtf(ss * (1.0f / 64.0f) + EPS) * (kind == 0 ? C2 : 1.0f);
                const float* g = kind == 0 ? qg : kg;
                const int head = (u.pn & 3) * 4 + wc;
                float* kn = row0 < MP ? out + OFF_KP + (size_t)row * AW : out + OFF_KS + (size_t)(row - MP) * AW;
#pragma unroll
                for (int bj = 0; bj < 2; ++bj) {
                    const int d0 = 32 * bj + 8 * fq, col = head * 64 + d0;
                    const f32x4 g0 = *(const f32x4*)(g + d0), g1 = *(const f32x4*)(g + d0 + 4);
                    const f32x4 v0 = acc[ai][bj][m][0] * sc * g0, v1 = acc[ai][bj][m][1] * sc * g1;
                    if (kind == 0) { *(u32x4*)(Q + (size_t)row * AW + col) = pack8(v0, v1); }
                    else { *(f32x4*)(kn + col) = v0; *(f32x4*)(kn + col + 4) = v1; *(u32x4*)(Kb + (size_t)row * AW + col) = pack8(v0, v1); }
                }
            } else if (kind == 2) {
                float* vn = row0 < MP ? out + OFF_VP + (size_t)row * AW : out + OFF_VS + (size_t)(row - MP) * AW;
#pragma unroll
                for (int bj = 0; bj < 2; ++bj) {
                    const int col = (u.pn - 8) * 256 + 64 * wc + 32 * bj + 8 * fq;
                    const f32x4 v0 = acc[ai][bj][m][0], v1 = acc[ai][bj][m][1];
                    *(f32x4*)(vn + col) = v0; *(f32x4*)(vn + col + 4) = v1; *(u32x4*)(Vb + (size_t)row * AW + col) = pack8(v0, v1);
                }
            } else if (kind == 3) {
#pragma unroll
                for (int bj = 0; bj < 2; ++bj) {
                    const int col = (u.pn - 12) * 256 + 64 * wc + 32 * bj + 8 * fq;
                    *(f32x4*)(U + (size_t)row * PW + col) = acc[ai][bj][m][0]; *(f32x4*)(U + (size_t)row * PW + col + 4) = acc[ai][bj][m][1];
                }
            } else {
                bf16_t* S = kind < 6 ? SGA : SGB;
                const int cb = (kind < 6 ? u.pn - 16 : u.pn - 24) * 256;
#pragma unroll
                for (int bj = 0; bj < 2; ++bj) {
                    const int col = cb + 64 * wc + 32 * bj + 8 * fq;
                    f32x4 v0 = acc[ai][bj][m][0], v1 = acc[ai][bj][m][1];
#pragma unroll
                    for (int e = 0; e < 4; ++e) { v0[e] = sigm(v0[e]); v1[e] = sigm(v1[e]); }
                    *(u32x4*)(S + (size_t)row * DM + col) = pack8(v0, v1);
                }
            }
        EPI_ROWS_END
    }
};
struct EpiPool {
    static constexpr bool PERM = true;
    const bf16_t* SGB; const float* ps; bf16_t* MIX;
    __device__ __forceinline__ void operator()(const f32x4 (&acc)[2][2][4][2], const Unit& u, int wr, int wc, int fr, int fq) const {
        EPI_ROWS_BEGIN
#pragma unroll
            for (int bj = 0; bj < 2; ++bj) {
                const int col = u.pn * BM + bj * HALF + wc * 32 + 8 * fq;
                f32x4 s0, s1; unpack8(*(const u32x4*)(SGB + (size_t)row * DM + col), s0, s1);
                const f32x4 p0 = *(const f32x4*)(ps + col), p1 = *(const f32x4*)(ps + col + 4);
                *(u32x4*)(MIX + (size_t)row * DM + col) = pack8(acc[ai][bj][m][0] * p0 * s0, acc[ai][bj][m][1] * p1 * s1);
            }
        EPI_ROWS_END
    }
};
struct EpiProj {
    static constexpr bool PERM = true;
    const bf16_t* SGA; bf16_t* MIX;
    __device__ __forceinline__ void operator()(const f32x4 (&acc)[2][2][4][2], const Unit& u, int wr, int wc, int fr, int fq) const {
        EPI_ROWS_BEGIN
#pragma unroll
            for (int bj = 0; bj < 2; ++bj) {
                const int col = u.pn * BM + bj * HALF + wc * 32 + 8 * fq;
                f32x4 s0, s1, q0, q1; unpack8(*(const u32x4*)(SGA + (size_t)row * DM + col), s0, s1); unpack8(*(const u32x4*)(MIX + (size_t)row * DM + col), q0, q1);
                *(u32x4*)(MIX + (size_t)row * DM + col) = pack8(acc[ai][bj][m][0] * s0 + q0, acc[ai][bj][m][1] * s1 + q1);
            }
        EPI_ROWS_END
    }
};
struct EpiOut {
    static constexpr bool PERM = true;
    const float *xp, *xs; float* H; bf16_t* HB; float* SS;
    __device__ __forceinline__ void operator()(const f32x4 (&acc)[2][2][4][2], const Unit& u, int wr, int wc, int fr, int fq) const {
        EPI_ROWS_BEGIN
            const float* xr = row0 < MP ? xp + (size_t)row * DM : xs + (size_t)(row - MP) * DM;
            float ss = 0.f;
#pragma unroll
            for (int bj = 0; bj < 2; ++bj) {
                const int col = u.pn * BM + bj * HALF + wc * 32 + 8 * fq;
                const f32x4 h0 = *(const f32x4*)(xr + col) + acc[ai][bj][m][0], h1 = *(const f32x4*)(xr + col + 4) + acc[ai][bj][m][1];
                *(f32x4*)(H + (size_t)row * DM + col) = h0; *(f32x4*)(H + (size_t)row * DM + col + 4) = h1;
                *(u32x4*)(HB + (size_t)row * DM + col) = pack8(h0, h1);
                ss += (h0[0] * h0[0] + h0[1] * h0[1]) + (h0[2] * h0[2] + h0[3] * h0[3]) + (h1[0] * h1[0] + h1[1] * h1[1]) + (h1[2] * h1[2] + h1[3] * h1[3]);
            }
            ss += __shfl_xor(ss, 16); ss += __shfl_xor(ss, 32);
            if (fq == 0) SS[(size_t)row * 32 + u.pn * 4 + wc] = ss;
        EPI_ROWS_END
    }
};
struct EpiGU {
    static constexpr bool PERM = true;
    const float* SS; bf16_t* ACT;
    __device__ __forceinline__ void operator()(const f32x4 (&acc)[2][2][4][2], const Unit& u, int wr, int wc, int fr, int fq) const {
        EPI_ROWS_BEGIN
            const f32x4* sp = (const f32x4*)(SS + (size_t)row * 32);
            f32x4 t = sp[0];
#pragma unroll
            for (int j = 1; j < 8; ++j) t += sp[j];
            const float rstd = rsqrtf(((t[0] + t[1]) + (t[2] + t[3])) * (1.0f / DM) + EPS);
            const int col = u.pn * HALF + wc * 32 + 8 * fq;
            f32x4 a0, a1;
#pragma unroll
            for (int e = 0; e < 4; ++e) { const float g0 = acc[ai][0][m][0][e] * rstd, g1 = acc[ai][0][m][1][e] * rstd;
                a0[e] = g0 * sigm(g0) * (acc[ai][1][m][0][e] * rstd); a1[e] = g1 * sigm(g1) * (acc[ai][1][m][1][e] * rstd); }
            *(u32x4*)(ACT + (size_t)row * DFF + col) = pack8(a0, a1);
        EPI_ROWS_END
    }
};
struct EpiDown {
    static constexpr bool PERM = true;
    float* H;
    __device__ __forceinline__ void operator()(const f32x4 (&acc)[2][2][4][2], const Unit& u, int wr, int wc, int fr, int fq) const {
        EPI_ROWS_BEGIN
#pragma unroll
            for (int bj = 0; bj < 2; ++bj) {
                float* hp = H + (size_t)row * DM + u.pn * BM + bj * HALF + wc * 32 + 8 * fq;
                const f32x4 y0 = *(const f32x4*)hp + acc[ai][bj][m][0], y1 = *(const f32x4*)(hp + 4) + acc[ai][bj][m][1];
                *(f32x4*)hp = y0; *(f32x4*)(hp + 4) = y1;
            }
        EPI_ROWS_END
    }
};
}


namespace sk {
constexpr int PSTR = 68, PART_FLOATS = 32 * PSTR, RED_OFF = 8 * PART_FLOATS * 4;
template <int UNR, class Epi>
__device__ __forceinline__ void unit(LAS unsigned char* lds, const bf16_t* A, int lda, const bf16_t* B0, const bf16_t* B1, int ldb, int K, const Epi& E, int j) {
    const int tid = threadIdx.x, lane = tid & 63, r32 = lane & 31, hi = lane >> 5; const int wid = __builtin_amdgcn_readfirstlane(tid >> 6);
    const int kc = K >> 3;
    const bf16_t* ap = A + (size_t)r32 * lda + wid * kc + hi * 8;
    const bf16_t* b0 = B0 + (size_t)r32 * ldb + wid * kc + hi * 8;
    const bf16_t* b1 = B1 + (size_t)r32 * ldb + wid * kc + hi * 8;
    f32x16 acc0 = f32x16{}, acc1 = f32x16{};
    for (int k0 = 0; k0 < kc; k0 += 16 * UNR) {
        bf16x8 af[UNR], f0[UNR], f1[UNR];
#pragma unroll
        for (int i = 0; i < UNR; ++i) { af[i] = *(const bf16x8*)(ap + k0 + 16 * i); f0[i] = *(const bf16x8*)(b0 + k0 + 16 * i); f1[i] = *(const bf16x8*)(b1 + k0 + 16 * i); }
#pragma unroll
        for (int i = 0; i < UNR; ++i) { acc0 = __builtin_amdgcn_mfma_f32_32x32x16_bf16(f0[i], af[i], acc0, 0, 0, 0); acc1 = __builtin_amdgcn_mfma_f32_32x32x16_bf16(f1[i], af[i], acc1, 0, 0, 0); }
    }
    LAS float* part = (LAS float*)lds + wid * PART_FLOATS + r32 * PSTR + 4 * hi;
#pragma unroll
    for (int g = 0; g < 4; ++g) {
        *(LAS f32x4*)(part + 8 * g) = (f32x4){acc0[4 * g], acc0[4 * g + 1], acc0[4 * g + 2], acc0[4 * g + 3]};
        *(LAS f32x4*)(part + 32 + 8 * g) = (f32x4){acc1[4 * g], acc1[4 * g + 1], acc1[4 * g + 2], acc1[4 * g + 3]};
    }
    __syncthreads();
    { const int m = tid >> 4, c4 = (tid & 15) * 4; const LAS float* pp = (const LAS float*)lds + m * PSTR + c4;
      f32x4 t = *(const LAS f32x4*)pp;
#pragma unroll
      for (int w = 1; w < 8; ++w) t += *(const LAS f32x4*)(pp + w * PART_FLOATS);
      *(LAS f32x4*)((LAS float*)(lds + RED_OFF) + m * PSTR + c4) = t; }
    __syncthreads();
    E.run((const LAS float*)(lds + RED_OFF), j, tid);
}
__device__ __forceinline__ float sum16(float v) { v += __shfl_xor(v, 1); v += __shfl_xor(v, 2); v += __shfl_xor(v, 4); v += __shfl_xor(v, 8); return v; }
__device__ __forceinline__ u32x2 pack4(const f32x4 a) { return (u32x2){cvtpk(a[0], a[1]), cvtpk(a[2], a[3])}; }
__device__ __forceinline__ f32x4 unpack4(const u32x2 w) { return (f32x4){bflo(w.x), bfhi(w.x), bflo(w.y), bfhi(w.y)}; }
struct SkIn {
    bf16_t *Q, *Kb, *Vb, *SGA, *SGB; float* U; float* out; const float *qg, *kg;
    __device__ __forceinline__ void run(const LAS float* red, int j, int tid) const {
        const int m = tid >> 4, c4 = (tid & 15) * 4, kind = j >> 4; const size_t row = MP + m;
        f32x4 v = *(const LAS f32x4*)(red + m * PSTR + c4);
        if (kind <= 1) {
            const float ss = sum16((v[0] * v[0] + v[1] * v[1]) + (v[2] * v[2] + v[3] * v[3]));
            const float sc = rsqrtf(ss * (1.0f / 64.0f) + EPS) * (kind == 0 ? C2 : 1.0f);
            const f32x4 g = *(const f32x4*)((kind == 0 ? qg : kg) + c4);
            v = v * sc * g;
            const int col = (j & 15) * 64 + c4;
            if (kind == 0) *(u32x2*)(Q + row * AW + col) = pack4(v);
            else { *(f32x4*)(out + OFF_KS + (size_t)m * AW + col) = v; *(u32x2*)(Kb + row * AW + col) = pack4(v); }
        } else if (kind == 2) { const int col = (j - 32) * 64 + c4; *(f32x4*)(out + OFF_VS + (size_t)m * AW + col) = v; *(u32x2*)(Vb + row * AW + col) = pack4(v); }
        else if (kind == 3) { *(f32x4*)(U + row * PW + (j - 48) * 64 + c4) = v; }
        else { bf16_t* S = kind < 6 ? SGA : SGB; const int col = (kind < 6 ? j - 64 : j - 96) * 64 + c4;
#pragma unroll
            for (int e = 0; e < 4; ++e) v[e] = sigm(v[e]);
            *(u32x2*)(S + row * DM + col) = pack4(v); }
    }
};
struct SkPool {
    const bf16_t* SGB; const float* ps; bf16_t* MIX;
    __device__ __forceinline__ void run(const LAS float* red, int j, int tid) const {
        const int m = tid >> 4, c4 = (tid & 15) * 4, col = j * 64 + c4; const size_t row = MP + m;
        const f32x4 v = *(const LAS f32x4*)(red + m * PSTR + c4);
        *(u32x2*)(MIX + row * DM + col) = pack4(v * *(const f32x4*)(ps + col) * unpack4(*(const u32x2*)(SGB + row * DM + col)));
    }
};
struct SkProj {
    const bf16_t* SGA; bf16_t* MIX;
    __device__ __forceinline__ void run(const LAS float* red, int j, int tid) const {
        const int m = tid >> 4, c4 = (tid & 15) * 4, col = j * 64 + c4; const size_t row = MP + m;
        const f32x4 v = *(const LAS f32x4*)(red + m * PSTR + c4);
        *(u32x2*)(MIX + row * DM + col) = pack4(v * unpack4(*(const u32x2*)(SGA + row * DM + col)) + unpack4(*(const u32x2*)(MIX + row * DM + col)));
    }
};
struct SkOut {
    const float* xs; float* H; bf16_t* HB; float* SS;
    __device__ __forceinline__ void run(const LAS float* red, int j, int tid) const {
        const int m = tid >> 4, c4 = (tid & 15) * 4, col = j * 64 + c4; const size_t row = MP + m;
        const f32x4 h = *(const LAS f32x4*)(red + m * PSTR + c4) + *(const f32x4*)(xs + (size_t)m * DM + col);
        *(f32x4*)(H + row * DM + col) = h; *(u32x2*)(HB + row * DM + col) = pack4(h);
        const float ss = sum16((h[0] * h[0] + h[1] * h[1]) + (h[2] * h[2] + h[3] * h[3]));
        if ((tid & 15) == 0) SS[row * 32 + j] = ss;
    }
};
struct SkGU {
    const float* SS; bf16_t* ACT;
    __device__ __forceinline__ void run(const LAS float* red, int j, int tid) const {
        if (tid < 256) {
            const int m = tid >> 3, i4 = (tid & 7) * 4; const size_t row = MP + m;
            const f32x4* sp = (const f32x4*)(SS + row * 32);
            f32x4 t = sp[0];
#pragma unroll
            for (int q = 1; q < 8; ++q) t += sp[q];
            const float rstd = rsqrtf(((t[0] + t[1]) + (t[2] + t[3])) * (1.0f / DM) + EPS);
            const f32x4 g = *(const LAS f32x4*)(red + m * PSTR + i4) * rstd, up = *(const LAS f32x4*)(red + m * PSTR + 32 + i4) * rstd;
            f32x4 a;
#pragma unroll
            for (int e = 0; e < 4; ++e) a[e] = g[e] * sigm(g[e]) * up[e];
            *(u32x2*)(ACT + row * DFF + j * 32 + i4) = pack4(a);
        }
    }
};
struct SkDown {
    float* H;
    __device__ __forceinline__ void run(const LAS float* red, int j, int tid) const {
        const int m = tid >> 4, c4 = (tid & 15) * 4; float* hp = H + (size_t)(MP + m) * DM + j * 64 + c4;
        *(f32x4*)hp = *(const f32x4*)hp + *(const LAS f32x4*)(red + m * PSTR + c4);
    }
};
}

namespace att {
typedef short v4i16_t __attribute__((ext_vector_type(4)));
typedef LAS const char* lds_cptr;
constexpr int LDS_K = 0, LDS_V = 16384, LDS_OST = 32768, LDS_BYTES = 65536;
__device__ __forceinline__ s16x4 vtr(lds_cptr p) { return __builtin_bit_cast(s16x4, __builtin_amdgcn_ds_read_tr16_b64_v4i16((LAS v4i16_t*)p)); }

template <int MODE>
__device__ __forceinline__ void sb_tile(f32x16 (&o)[2], float& carry, const bf16x8 (&qr)[4], lds_cptr kp, lds_cptr vp, const f32x16& bias16, int qrel, int hi) {
    f32x16 p0, p1;
#pragma unroll
    for (int d0 = 0; d0 < 4; ++d0) {
        const bf16x8 b0 = *(const LAS bf16x8*)(kp + d0 * 2048), b1 = *(const LAS bf16x8*)(kp + d0 * 2048 + 512);
        if (d0 == 0) { p0 = __builtin_amdgcn_mfma_f32_32x32x16_bf16(b0, qr[0], bias16, 0, 0, 0); p1 = __builtin_amdgcn_mfma_f32_32x32x16_bf16(b1, qr[0], bias16, 0, 0, 0); }
        else { p0 = __builtin_amdgcn_mfma_f32_32x32x16_bf16(b0, qr[d0], p0, 0, 0, 0); p1 = __builtin_amdgcn_mfma_f32_32x32x16_bf16(b1, qr[d0], p1, 0, 0, 0); }
    }
    if (MODE == 1) {
#pragma unroll
        for (int r = 0; r < 16; ++r) { const int kv = (r & 3) + 8 * (r >> 2) + 4 * hi; if (kv >= qrel) p0[r] = -INFINITY; if (kv + 32 >= qrel) p1[r] = -INFINITY; }
    }
    float e[32], G[8];
#pragma unroll
    for (int r = 0; r < 16; ++r) { e[r] = __builtin_amdgcn_exp2f(p0[r]); e[16 + r] = __builtin_amdgcn_exp2f(p1[r]); }
#pragma unroll
    for (int gi = 0; gi < 8; ++gi) {
        const float d0 = 1.0f + e[4 * gi], d1 = 1.0f + e[4 * gi + 1], d2 = 1.0f + e[4 * gi + 2], d3 = 1.0f + e[4 * gi + 3];
        const float pr2 = d0 * d1, pr3 = pr2 * d2;
        G[gi] = __builtin_amdgcn_rcpf(pr3 * d3);
        e[4 * gi + 1] *= d0; e[4 * gi + 2] *= pr2; e[4 * gi + 3] *= pr3;
    }
    float S = carry;
#pragma unroll
    for (int gi = 7; gi >= 0; --gi) {
        const auto rr = __builtin_amdgcn_permlane32_swap(__float_as_uint(G[gi]), __float_as_uint(G[gi]), false, false);
        const float Glo = __uint_as_float(rr[0]), Ghi = __uint_as_float(rr[1]);
        const float F = (hi ? S : S * Ghi) * G[gi];
#pragma unroll
        for (int j = 0; j < 4; ++j) e[4 * gi + j] *= F;
        S = S * (Glo * Ghi);
    }
    carry = S;
    bf16x8 pa[4];
#pragma unroll
    for (int ks = 0; ks < 4; ++ks) { u32x4 w; w.x = cvtpk(e[8 * ks], e[8 * ks + 1]); w.y = cvtpk(e[8 * ks + 2], e[8 * ks + 3]); w.z = cvtpk(e[8 * ks + 4], e[8 * ks + 5]); w.w = cvtpk(e[8 * ks + 6], e[8 * ks + 7]);
        pa[ks] = __builtin_bit_cast(bf16x8, w); }
#pragma unroll
    for (int dh = 0; dh < 2; ++dh)
#pragma unroll
        for (int ks = 0; ks < 4; ++ks) {
            const s16x4 lo = vtr(vp + dh * 4096 + ks * 1024), hi4 = vtr(vp + dh * 4096 + ks * 1024 + 512);
            const bf16x8 vf = (bf16x8){lo[0], lo[1], lo[2], lo[3], hi4[0], hi4[1], hi4[2], hi4[3]};
            o[dh] = __builtin_amdgcn_mfma_f32_32x32x16_bf16(pa[ks], vf, o[dh], 0, 0, 0);
        }
}

__device__ __forceinline__ void prompt_unit(int b, int h, int qb, const bf16_t* Q, const bf16_t* K, const bf16_t* V, bf16_t* O, const float* sbb, LAS unsigned char* lds) {
    const int tid = threadIdx.x, lane = tid & 63, r32 = lane & 31, hi = lane >> 5; const int wid = __builtin_amdgcn_readfirstlane(tid >> 6);
    const size_t rowbase = (size_t)b * SEQ; const int q0 = qb * 256;
    const bf16_t* Qw = Q + (rowbase + q0 + wid * 32) * AW + h * HD;
    const bf16_t* Kh = K + rowbase * AW + h * HD; const bf16_t* Vh = V + rowbase * AW + h * HD;
    const bf16_t* ksrc = Kh + (size_t)lane * AW + wid * 8;
    const bf16_t* vsrc = Vh + (size_t)(16 * (wid & 3) + (lane >> 2)) * AW + (wid >> 2) * 32 + (lane & 3) * 8;
    const lds_cptr l3 = (lds_cptr)lds;
    const lds_cptr kp0 = l3 + LDS_K + hi * 1024 + r32 * 16;
    const lds_cptr vp0 = l3 + LDS_V + ((lane >> 4) & 1) * 32 + (lane & 3) * 8 + (4 * hi + ((lane & 15) >> 2)) * 64;
#define ATT_DMA(t, slot) do { \
        __builtin_amdgcn_global_load_lds((const unsigned*)(ksrc + (size_t)(t) * 64 * AW), (LAS unsigned*)(lds + LDS_K + (slot) * 8192 + wid * 1024), 16, 0, 0); \
        __builtin_amdgcn_global_load_lds((const unsigned*)(vsrc + (size_t)(t) * 64 * AW), (LAS unsigned*)(lds + LDS_V + (slot) * 8192 + wid * 1024), 16, 0, 0); } while (0)
    const int NT = (q0 + 256) / 64;
    ATT_DMA(NT - 1, 0);
    bf16x8 qr[4];
#pragma unroll
    for (int d0 = 0; d0 < 4; ++d0) qr[d0] = *(const bf16x8*)(Qw + (size_t)r32 * AW + d0 * 16 + hi * 8);
    const float bias2 = sbb[h] * LOG2E;
    f32x16 bias16;
#pragma unroll
    for (int r = 0; r < 16; ++r) bias16[r] = bias2;
    f32x16 o[2]; o[0] = f32x16{}; o[1] = f32x16{};
    float carry = 1.0f;
    asm volatile("s_waitcnt vmcnt(0)" ::: "memory"); __builtin_amdgcn_s_barrier();
    int slot = 0;
    for (int t = NT - 1; t >= 0; --t) {
        if (t > 0) ATT_DMA(t - 1, slot ^ 1);
        const int qmin = q0 + wid * 32 - 64 * t;
        if (qmin + 31 > 0) {
            if (qmin >= 64) sb_tile<0>(o, carry, qr, kp0 + slot * 8192, vp0 + slot * 8192, bias16, 0, hi);
            else sb_tile<1>(o, carry, qr, kp0 + slot * 8192, vp0 + slot * 8192, bias16, qmin + r32, hi);
        }
        asm volatile("s_waitcnt vmcnt(0) lgkmcnt(0)" ::: "memory"); __builtin_amdgcn_s_barrier();
        slot ^= 1;
    }
#undef ATT_DMA
    LAS bf16_t* stg = (LAS bf16_t*)(lds + LDS_OST) + wid * 2048;
#pragma unroll
    for (int r = 0; r < 16; ++r) { const int orow = (r & 3) + 8 * (r >> 2) + 4 * hi;
#pragma unroll
        for (int dh = 0; dh < 2; ++dh) stg[orow * 64 + dh * 32 + r32] = (bf16_t)(cvtpk(o[dh][r], 0.f) & 0xffffu); }
    asm volatile("s_waitcnt lgkmcnt(0)" ::: "memory");
    bf16_t* Ow = O + (rowbase + q0 + wid * 32) * AW + h * HD;
#pragma unroll
    for (int i = 0; i < 4; ++i) { const int row = i * 8 + (lane >> 3), ch = lane & 7; const u32x4 v = *(const LAS u32x4*)(stg + row * 64 + ch * 8); *(u32x4*)(Ow + (size_t)row * AW + ch * 8) = v; }
    asm volatile("s_waitcnt lgkmcnt(0)" ::: "memory"); __builtin_amdgcn_s_barrier();
}

__device__ __forceinline__ void decode_unit(int b, int c, const bf16_t* Q, const float* ck, const float* cv, const int* pt, const float* sbb, float* DPO, float* DPW, LAS unsigned char* lds) {
    const int tid = threadIdx.x, lane = tid & 63, r32 = lane & 31, hi = lane >> 5; const int wid = __builtin_amdgcn_readfirstlane(tid >> 6);
    LAS unsigned char* wl = lds + wid * 16384;
    const lds_cptr kp0 = (lds_cptr)wl + hi * 1024 + r32 * 16;
    const lds_cptr vp0 = (lds_cptr)wl + 8192 + ((lane >> 4) & 1) * 32 + (lane & 3) * 8 + (4 * hi + ((lane & 15) >> 2)) * 64;
    const int tk = lane >> 4, d4 = (lane & 15) * 4;
    LAS unsigned char* kw = wl + (d4 >> 3) * 1024 + (d4 & 7) * 2;
    LAS unsigned char* vw = wl + 8192 + (d4 >> 5) * 4096 + (d4 & 31) * 2;
    for (int hh = 0; hh < 2; ++hh) {
        const int h = 2 * wid + hh;
        bf16x8 qr[4];
#pragma unroll
        for (int d0 = 0; d0 < 4; ++d0) { qr[d0] = (bf16x8){0, 0, 0, 0, 0, 0, 0, 0}; if (r32 < DS) qr[d0] = *(const bf16x8*)(Q + (size_t)(MP + b * DS + r32) * AW + h * HD + d0 * 16 + hi * 8); }
        const float bias2 = sbb[h] * LOG2E;
        f32x16 bias16;
#pragma unroll
        for (int r = 0; r < 16; ++r) bias16[r] = bias2;
        f32x16 o[2]; o[0] = f32x16{}; o[1] = f32x16{};
        float carry = 1.0f;
        for (int tt = 7; tt >= 0; --tt) {
            const int page = pt[b * NPG + c * 4 + (tt >> 1)];
            const size_t tok0 = (size_t)page * PAGE + (tt & 1) * 64;
            const float* kb = ck + ((tok0 + tk) * NH + h) * HD + d4;
            const float* vb = cv + ((tok0 + tk) * NH + h) * HD + d4;
            f32x4 kr[16];
#pragma unroll
            for (int i = 0; i < 16; ++i) kr[i] = __builtin_nontemporal_load((const f32x4*)(kb + (size_t)i * 4 * NH * HD));
#pragma unroll
            for (int i = 0; i < 16; ++i) { u32x2 w; w.x = cvtpk(kr[i][0], kr[i][1]); w.y = cvtpk(kr[i][2], kr[i][3]); *(LAS u32x2*)(kw + (4 * i + tk) * 16) = w; }
#pragma unroll
            for (int i = 0; i < 16; ++i) kr[i] = __builtin_nontemporal_load((const f32x4*)(vb + (size_t)i * 4 * NH * HD));
#pragma unroll
            for (int i = 0; i < 16; ++i) { u32x2 w; w.x = cvtpk(kr[i][0], kr[i][1]); w.y = cvtpk(kr[i][2], kr[i][3]); *(LAS u32x2*)(vw + (4 * i + tk) * 64) = w; }
            asm volatile("s_waitcnt lgkmcnt(0)" ::: "memory");
            sb_tile<0>(o, carry, qr, kp0, vp0, bias16, 0, hi);
            asm volatile("s_waitcnt lgkmcnt(0)" ::: "memory");
        }
        if (hi == 0) {
            float* op = DPO + ((((size_t)b * NH + h) * DCH + c) * DS) * HD;
#pragma unroll
            for (int q = 0; q < DS; ++q)
#pragma unroll
                for (int dh = 0; dh < 2; ++dh) op[q * HD + dh * 32 + r32] = o[dh][q];
            if (r32 < DS) DPW[(((size_t)b * NH + h) * DCH + c) * DS + r32] = carry;
        }
    }
}
}

constexpr int NWAVES = 8;
constexpr int N_PHASES = 8;
constexpr size_t MiB = 1u << 20;
constexpr size_t WS_CTL = 0, CTL_ZERO_BYTES = 1 * MiB;
constexpr size_t WS_WIN = 2 * MiB, WS_WAP = 34 * MiB, WS_WPOOL = 38 * MiB, WS_WOUT = 40 * MiB, WS_WGU = 48 * MiB, WS_WD = 92 * MiB;
constexpr size_t WS_XN = 114 * MiB, WS_Q = 148 * MiB, WS_K = 165 * MiB, WS_V = 182 * MiB, WS_U = 199 * MiB, WS_SGA = 232 * MiB, WS_SGB = 265 * MiB;
constexpr size_t WS_P = 298 * MiB, WS_O = 315 * MiB, WS_MIX = 332 * MiB, WS_HB = 365 * MiB, WS_SS = 398 * MiB, WS_ACT = 400 * MiB, WS_DPO = 491 * MiB, WS_DPW = 495 * MiB, WS_END = 496 * MiB;
static_assert(WS_WIN + (size_t)INC * DM * 2 <= WS_WAP && WS_WAP + (size_t)DM * AW * 2 <= WS_WPOOL && WS_WPOOL + (size_t)DM * 256 * 2 <= WS_WOUT && WS_WOUT + (size_t)DM * DM * 2 <= WS_WGU &&
              WS_WGU + (size_t)2 * DFF * DM * 2 <= WS_WD && WS_WD + (size_t)DM * DFF * 2 <= WS_XN && WS_XN + (size_t)MPAD * DM * 2 <= WS_Q && WS_Q + (size_t)MPAD * AW * 2 <= WS_K &&
              WS_K + (size_t)MPAD * AW * 2 <= WS_V && WS_V + (size_t)MPAD * AW * 2 <= WS_U && WS_U + (size_t)MPAD * PW * 4 <= WS_SGA && WS_SGA + (size_t)MPAD * DM * 2 <= WS_SGB &&
              WS_SGB + (size_t)MPAD * DM * 2 <= WS_P && WS_P + (size_t)MPAD * PW * 2 <= WS_O && WS_O + (size_t)MPAD * AW * 2 <= WS_MIX && WS_MIX + (size_t)MPAD * DM * 2 <= WS_HB &&
              WS_HB + (size_t)MPAD * DM * 2 <= WS_SS && WS_SS + (size_t)MPAD * 32 * 4 <= WS_ACT && WS_ACT + (size_t)MPAD * DFF * 2 <= WS_DPO &&
              WS_DPO + (size_t)DB * NH * DCH * DS * HD * 4 <= WS_DPW && WS_DPW + (size_t)DB * NH * DCH * DS * 4 <= WS_END, "d_ws map");
constexpr int CW_TMO = 0, CW_PROBE = 64, CW_BAR = 4096;
constexpr int RING_OFF = 0, RING_BYTES = 131072;
constexpr int LDSCTL_OFF = RING_BYTES, MISC_OFF = LDSCTL_OFF + 320;
constexpr int LDS_BYTES = 147456;

typedef GAS unsigned gu32;
#define RLX_AGENT __ATOMIC_RELAXED, __HIP_MEMORY_SCOPE_AGENT
#define LDS_WAIT() asm volatile("s_waitcnt lgkmcnt(0)" ::: "memory")

#define XB_TMO      128
#define XB_XCNT(j)  (256  + 64 * (j))
#define XB_XSUB(j)  (1280 + 64 * (j))
#define XB_XGEN(j)  (2304 + 64 * (j))
#define XB_TOP      3328
#define XB_TOPGEN   3392
#define XCD_BAR_WORDS 3456
#define XB_SPIN_CAP (1u << 18)
__device__ __forceinline__ unsigned xb_ld(unsigned* p)              { return __hip_atomic_load(p, __ATOMIC_RELAXED, __HIP_MEMORY_SCOPE_AGENT); }
__device__ __forceinline__ unsigned xb_add(unsigned* p, unsigned v) { return __hip_atomic_fetch_add(p, v, __ATOMIC_RELAXED, __HIP_MEMORY_SCOPE_AGENT); }
__device__ __forceinline__ unsigned xb_xcc_id() { return (unsigned)__builtin_amdgcn_s_getreg((3 << 11) | 20) & 0xFu; }
#define XB_SPIN(cond, bar) do { unsigned _sp = 0; while (cond) { __builtin_amdgcn_s_sleep(1); \
    if ((++_sp & 255u) == 0u) { if (xb_ld(&(bar)[XB_TMO])) break; if (_sp > XB_SPIN_CAP) { atomicAdd(&(bar)[XB_TMO], 1u); break; } } } } while (0)
struct XcdBarrier { unsigned* bar; unsigned x; volatile LAS unsigned* st; };
__device__ __forceinline__ XcdBarrier xcd_barrier_post(unsigned* bar, volatile LAS unsigned* st) {
    XcdBarrier b; b.bar = bar; b.x = xb_xcc_id(); b.st = st;
    if (threadIdx.x == 0) (void)xb_add(&bar[XB_XCNT(b.x)], 1u);
    return b;
}
__device__ __forceinline__ void xcd_barrier_complete(unsigned* bar, unsigned x, unsigned& nloc, unsigned& nx) {
    const unsigned G = gridDim.x * gridDim.y * gridDim.z;
    unsigned sum, cnt, mine, sp = 0u;
    for (;;) {
        sum = 0u; cnt = 0u; mine = 0u;
#pragma unroll
        for (unsigned j = 0; j < 16; ++j) { const unsigned c = xb_ld(&bar[XB_XCNT(j)]); sum += c; cnt += (c > 0u) ? 1u : 0u; mine = (j == x) ? c : mine; }
        if (sum == G) break;
        __builtin_amdgcn_s_sleep(1);
        if ((++sp & 255u) == 0u) { if (xb_ld(&bar[XB_TMO])) break; if (sp > XB_SPIN_CAP) { atomicAdd(&bar[XB_TMO], 1u); break; } }
    }
    nloc = mine > 0u ? mine : 1u; nx = cnt > 0u ? cnt : 1u;
}
__device__ __forceinline__ void xcd_barrier(const XcdBarrier& b) {
    asm volatile("s_waitcnt vmcnt(0)" ::: "memory");
    __syncthreads();
    if (threadIdx.x == 0) {
        unsigned* bar = b.bar;
        __builtin_amdgcn_s_waitcnt(0);
        unsigned nloc = b.st[0], nx = b.st[1];
        if (nloc == 0u) { xcd_barrier_complete(bar, b.x, nloc, nx); b.st[0] = nloc; b.st[1] = nx; }
        const unsigned old = xb_add(&bar[XB_XSUB(b.x)], 1u);
        const unsigned gen = old / nloc;
        if (old + 1u == (gen + 1u) * nloc) {
            __builtin_amdgcn_fence(__ATOMIC_RELEASE, "agent");
            asm volatile("s_waitcnt vmcnt(0)" ::: "memory");
            const unsigned og = xb_add(&bar[XB_TOP], 1u);
            const unsigned tg = og / nx;
            if (og + 1u == (tg + 1u) * nx) xb_add(&bar[XB_TOPGEN], 1u);
            else XB_SPIN(xb_ld(&bar[XB_TOPGEN]) == tg, bar);
            __builtin_amdgcn_fence(__ATOMIC_ACQUIRE, "agent");
            xb_add(&bar[XB_XGEN(b.x)], 1u);
            asm volatile("s_waitcnt vmcnt(0)" ::: "memory");
        } else {
            XB_SPIN(xb_ld(&bar[XB_XGEN(b.x)]) == gen, bar);
            __builtin_amdgcn_fence(__ATOMIC_ACQUIRE, "agent");
            asm volatile("s_waitcnt vmcnt(0)" ::: "memory");
        }
    }
    __syncthreads();
}

__device__ __forceinline__ float wave_sum(float v) {
#pragma unroll
    for (int o = 1; o < 64; o <<= 1) v += __shfl_xor(v, o);
    return v;
}

__device__ __forceinline__ void p0_transpose_item(const float* src, int ldn, bf16_t* dst, int ldk, const float* ksc, LAS float* scr, int lane) {
    f32x4 v[8];
#pragma unroll
    for (int i = 0; i < 8; ++i) v[i] = *(const f32x4*)(src + (size_t)(8 * i + (lane >> 3)) * ldn + 4 * (lane & 7));
#pragma unroll
    for (int i = 0; i < 8; ++i) { const int kk = 8 * i + (lane >> 3); f32x4 x = v[i]; if (ksc) x *= ksc[kk]; LAS float* d = scr + kk * 33 + 4 * (lane & 7); d[0] = x[0]; d[1] = x[1]; d[2] = x[2]; d[3] = x[3]; }
    LDS_WAIT(); asm volatile("" ::: "memory");
    const int c = lane & 7;
#pragma unroll
    for (int j = 0; j < 4; ++j) { const int n = (lane >> 3) + 8 * j; const LAS float* s = scr + (8 * c) * 33 + n;
        u32x4 o; o.x = cvtpk(s[0 * 33], s[1 * 33]); o.y = cvtpk(s[2 * 33], s[3 * 33]); o.z = cvtpk(s[4 * 33], s[5 * 33]); o.w = cvtpk(s[6 * 33], s[7 * 33]);
        *(u32x4*)(dst + (size_t)n * ldk + 8 * c) = o; }
    LDS_WAIT(); asm volatile("" ::: "memory");
}

struct Args { const void* in[18]; float* out; unsigned char* ws; int ph_lo, ph_hi, li, pad; };

__global__ void __launch_bounds__(NWAVES * 64, 2) fwd_kernel(Args args) {
    extern __shared__ __attribute__((aligned(16))) unsigned char lds_raw[];
    LAS unsigned char* lds = (LAS unsigned char*)lds_raw;
    volatile LAS unsigned* MISC = (volatile LAS unsigned*)(lds + MISC_OFF);
    const int tid = threadIdx.x, lane = tid & 63, wave = __builtin_amdgcn_readfirstlane(tid >> 6);
    const int G = gridDim.x; const int bx = blockIdx.x; const int vcu = (G % 8 == 0) ? (bx % 8) * (G / 8) + bx / 8 : bx;
    const int gw = vcu * NWAVES + wave, NGW = G * NWAVES;
    unsigned char* ws = args.ws;
    unsigned* ctl = (unsigned*)(ws + WS_CTL);
    const float* x_p = (const float*)args.in[0]; const float* x_s = (const float*)args.in[1];
    const float* cache_k = (const float*)args.in[2]; const float* cache_v = (const float*)args.in[3];
    const float* state_pool = (const float*)args.in[4]; const int* page_table = (const int*)args.in[5];
    const float* norm1_g = (const float*)args.in[6]; const float* w_in = (const float*)args.in[7];
    const float* q_g = (const float*)args.in[8]; const float* k_g = (const float*)args.in[9]; const float* sb_bias = (const float*)args.in[10];
    const float* w_ap = (const float*)args.in[11]; const float* w_pool = (const float*)args.in[12]; const float* pool_scale = (const float*)args.in[13];
    const float* w_out = (const float*)args.in[14]; const float* norm2_g = (const float*)args.in[15]; const float* w_gu = (const float*)args.in[16]; const float* w_down = (const float*)args.in[17];
    float* out = args.out;
    bf16_t* Win_t = (bf16_t*)(ws + WS_WIN); bf16_t* Wap_t = (bf16_t*)(ws + WS_WAP); bf16_t* Wpool_t = (bf16_t*)(ws + WS_WPOOL); bf16_t* Wout_t = (bf16_t*)(ws + WS_WOUT);
    bf16_t* Wgu_t = (bf16_t*)(ws + WS_WGU); bf16_t* Wd_t = (bf16_t*)(ws + WS_WD);
    bf16_t* XN = (bf16_t*)(ws + WS_XN); bf16_t* Qb = (bf16_t*)(ws + WS_Q); bf16_t* Kb = (bf16_t*)(ws + WS_K); bf16_t* Vb = (bf16_t*)(ws + WS_V);
    float* U = (float*)(ws + WS_U); bf16_t* SGA = (bf16_t*)(ws + WS_SGA); bf16_t* SGB = (bf16_t*)(ws + WS_SGB); bf16_t* Pb = (bf16_t*)(ws + WS_P); bf16_t* Ob = (bf16_t*)(ws + WS_O);
    bf16_t* MIX = (bf16_t*)(ws + WS_MIX); bf16_t* HB = (bf16_t*)(ws + WS_HB); float* SS = (float*)(ws + WS_SS); bf16_t* ACT = (bf16_t*)(ws + WS_ACT);
    float* DPO = (float*)(ws + WS_DPO); float* DPW = (float*)(ws + WS_DPW);

    for (int u = tid; u < (LDS_BYTES - LDSCTL_OFF) / 4; u += NWAVES * 64) ((LAS unsigned*)(lds + LDSCTL_OFF))[u] = 0u;
    __syncthreads();
    XcdBarrier bar; bar.bar = ctl + CW_BAR + args.li * XCD_BAR_WORDS; bar.x = 0; bar.st = nullptr;
    if (MK_N_LAUNCHES != N_PHASES) bar = xcd_barrier_post(ctl + CW_BAR + args.li * XCD_BAR_WORDS, MISC + 8);
    const int lo = args.ph_lo, hi_ph = args.ph_hi;
#define IN(k) (lo <= (k) && (k) < hi_ph)
#define BOTH(k) (IN(k) && IN((k) + 1))
#define GRID_BAR() do { if (MK_N_LAUNCHES != N_PHASES) xcd_barrier(bar); } while (0)
    unsigned long long tk0 = 0ull, tk1 = 0ull;
#define STAMPA(id) do { if (PROBE_T == (id) && tid == 0) tk0 = __builtin_amdgcn_s_memrealtime(); } while (0)
#define STAMPB(id) do { if (PROBE_T == (id) && tid == 0) atomicMax(ctl + CW_PROBE, (unsigned)(__builtin_amdgcn_s_memrealtime() - tk0)); } while (0)
#define STAMP(k) do { if (PROBE_T >= 0 && bx == PROBE_BLK && tid == 0) { if ((k) == PROBE_T) tk0 = __builtin_amdgcn_s_memrealtime(); if ((k) == PROBE_T + 1) tk1 = __builtin_amdgcn_s_memrealtime(); } } while (0)

    STAMP(0);
    if (IN(0)) {
        LAS float* scr = (LAS float*)(lds + RING_OFF + wave * 16384);
        constexpr int I_IN = (DM / 64) * (INC / 32), I_AP = (AW / 64) * (DM / 32), I_PL = 4 * (256 / 64) * (512 / 32), I_OUT = (DM / 64) * (DM / 32), I_GU = (DM / 64) * (2 * DFF / 32), I_DN = (DFF / 64) * (DM / 32);
        constexpr int NITEMS = I_IN + I_AP + I_PL + I_OUT + I_GU + I_DN;
        for (int it = gw; it < NITEMS; it += NGW) {
            int r = it;
            if (r < I_IN) { const int nblk = INC / 32, kb = r / nblk, nb = r % nblk, P0 = 32 * nb, pn = P0 >> 8, bj = (P0 >> 7) & 1, wc = (P0 >> 5) & 3, n0 = 256 * pn + 64 * wc + 32 * bj;
                p0_transpose_item(w_in + (size_t)(64 * kb) * INC + n0, INC, Win_t + (size_t)P0 * DM + 64 * kb, DM, nullptr, scr, lane); continue; } r -= I_IN;
            if (r < I_AP) { const int nblk = DM / 32, kb = r / nblk, nb = r % nblk;
                p0_transpose_item(w_ap + (size_t)(64 * kb) * DM + 32 * nb, DM, Wap_t + (size_t)(32 * nb) * AW + 64 * kb, AW, nullptr, scr, lane); continue; } r -= I_AP;
            if (r < I_PL) { const int gp = r / 64, r2 = r % 64, kb = r2 / 16, nb = r2 % 16;
                p0_transpose_item(w_pool + (size_t)gp * 256 * 512 + (size_t)(64 * kb) * 512 + 32 * nb, 512, Wpool_t + (size_t)(512 * gp + 32 * nb) * 256 + 64 * kb, 256, nullptr, scr, lane); continue; } r -= I_PL;
            if (r < I_OUT) { const int nblk = DM / 32, kb = r / nblk, nb = r % nblk;
                p0_transpose_item(w_out + (size_t)(64 * kb) * DM + 32 * nb, DM, Wout_t + (size_t)(32 * nb) * DM + 64 * kb, DM, nullptr, scr, lane); continue; } r -= I_OUT;
            if (r < I_GU) { const int nblk = 2 * DFF / 32, kb = r / nblk, nb = r % nblk, P0 = 32 * nb, pn = P0 >> 8, bj = (P0 >> 7) & 1, i0 = P0 & 127, n0 = bj * DFF + 128 * pn + i0;
                p0_transpose_item(w_gu + (size_t)(64 * kb) * (2 * DFF) + n0, 2 * DFF, Wgu_t + (size_t)P0 * DM + 64 * kb, DM, norm2_g + 64 * kb, scr, lane); continue; } r -= I_GU;
            { const int nblk = DM / 32, kb = r / nblk, nb = r % nblk;
                p0_transpose_item(w_down + (size_t)(64 * kb) * DM + 32 * nb, DM, Wd_t + (size_t)(32 * nb) * DFF + 64 * kb, DFF, nullptr, scr, lane); }
        }
        for (int mrow = gw; mrow < MR; mrow += NGW) {
            unsigned long long* o8 = (unsigned long long*)(XN + (size_t)mrow * DM) + lane;
            if (mrow < MR) {
                const float* xrow = mrow < MP ? x_p + (size_t)mrow * DM : x_s + (size_t)(mrow - MP) * DM;
                const f32x4* xr = (const f32x4*)xrow + lane;
                f32x4 v[8]; float s = 0.f;
#pragma unroll
                for (int j = 0; j < 8; ++j) { v[j] = xr[64 * j]; s += (v[j][0] * v[j][0] + v[j][1] * v[j][1]) + (v[j][2] * v[j][2] + v[j][3] * v[j][3]); }
                const float rstd = rsqrtf(wave_sum(s) * (1.0f / DM) + EPS);
#pragma unroll
                for (int j = 0; j < 8; ++j) { const f32x4 gg = *((const f32x4*)norm1_g + lane + 64 * j); const f32x4 y = v[j] * rstd * gg;
                    o8[64 * j] = (unsigned long long)cvtpk(y[0], y[1]) | ((unsigned long long)cvtpk(y[2], y[3]) << 32); }
            } else {
#pragma unroll
                for (int j = 0; j < 8; ++j) o8[64 * j] = 0ull;
            }
        }
        if (BOTH(0)) GRID_BAR();
    }

    STAMP(1);
    if (IN(1)) {
        pg8::Gemm g{XN, Win_t, DM, DM, DM, 0, 0}; pg8::StaticOrder S; S.init(MP, INC, G, bx);
        pg8::EpiIn E{Qb, Kb, Vb, SGA, SGB, U, out, q_g, k_g};
        pg8::gemm_phase<pg8::EpiIn, pg8::StaticOrder>(lds + RING_OFF, g, S, E);
        { sk::SkIn SE{Qb, Kb, Vb, SGA, SGB, U, out, q_g, k_g};
          for (int j = G - 1 - bx; j < INC / 64; j += G) { const bf16_t* Bp = Win_t + (size_t)(256 * (j >> 2) + 32 * (j & 3)) * DM;
              sk::unit<8>(lds + RING_OFF, XN + (size_t)MP * DM, DM, Bp, Bp + (size_t)128 * DM, DM, DM, SE, j); } }
        if (BOTH(1)) GRID_BAR();
    }

    STAMP(2);
    if (IN(2)) {
        STAMPA(22); STAMPA(24);
        for (int it = gw; it < (MP / 16) * 4; it += NGW) {
            const int rb = it >> 2, gp = it & 3, w = 2 << gp, row0 = rb * 16, pos0 = row0 & (SEQ - 1), c = 256 * gp + 4 * lane;
            const float* up = U + (size_t)row0 * PW + c;
            f32x4 s = (f32x4){0.f, 0.f, 0.f, 0.f};
            { f32x4 pre[15];
#pragma unroll
              for (int j = 1; j < 16; ++j) { pre[j - 1] = (f32x4){0.f, 0.f, 0.f, 0.f}; if (j < w && pos0 - j >= 0) pre[j - 1] = *(const f32x4*)(up - (long)j * PW); }
#pragma unroll
              for (int j = 0; j < 15; ++j) s += pre[j]; }
#pragma unroll
            for (int ch = 0; ch < 2; ++ch) {
                f32x4 ut[8], uo[8];
#pragma unroll
                for (int i = 0; i < 8; ++i) { const int ii = ch * 8 + i; ut[i] = *(const f32x4*)(up + (long)ii * PW);
                    uo[i] = (f32x4){0.f, 0.f, 0.f, 0.f}; if (pos0 + ii - (w - 1) >= 0) uo[i] = *(const f32x4*)(up + (long)(ii - (w - 1)) * PW); }
#pragma unroll
                for (int i = 0; i < 8; ++i) { const int ii = ch * 8 + i, pos = pos0 + ii;
                    s += ut[i];
                    const float cnt = (float)(pos + 1 < w ? pos + 1 : w);
                    const f32x4 p = s / cnt - ut[i];
                    *(u32x2*)(Pb + (size_t)(row0 + ii) * PW + c) = (u32x2){cvtpk(p[0], p[1]), cvtpk(p[2], p[3])};
                    s -= uo[i];
                    if (pos >= SEQ - PSTATE) *(f32x4*)(out + OFF_PP + ((size_t)(row0 / SEQ) * PSTATE + (pos - (SEQ - PSTATE))) * PW + c) = ut[i]; }
            }
        }
        for (int it = gw; it < DB * 4; it += NGW) {
            const int b = it >> 2, gp = it & 3, w = 2 << gp, c = 256 * gp + 4 * lane;
            const float* st = state_pool + (size_t)b * PSTATE * PW + c; const float* un = U + (size_t)(MP + b * DS) * PW + c;
            for (int i = 0; i < DS; ++i) {
                f32x4 s = (f32x4){0.f, 0.f, 0.f, 0.f};
                for (int j = 0; j < w; ++j) { const int e = PSTATE + i - j; s += e >= PSTATE ? *(const f32x4*)(un + (size_t)(e - PSTATE) * PW) : *(const f32x4*)(st + (size_t)e * PW); }
                const f32x4 ut = *(const f32x4*)(un + (size_t)i * PW);
                const f32x4 p = s / (float)w - ut;
                *(u32x2*)(Pb + (size_t)(MP + b * DS + i) * PW + c) = (u32x2){cvtpk(p[0], p[1]), cvtpk(p[2], p[3])};
            }
            for (int j = 0; j < PSTATE; ++j) { const int e = DS + j;
                *(f32x4*)(out + OFF_PS + ((size_t)b * PSTATE + j) * PW + c) = e >= PSTATE ? *(const f32x4*)(un + (size_t)(e - PSTATE) * PW) : *(const f32x4*)(st + (size_t)e * PW); }
        }
        __syncthreads();
        STAMPB(22); STAMPA(20);
        for (int half = 0; half < 2; ++half) {
            if ((half == 0) == ((vcu & 1) == 0)) {
                for (int id = vcu; id < DB * DCH; id += G) att::decode_unit(id / DCH, id % DCH, Qb, cache_k, cache_v, page_table, sb_bias, DPO, DPW, lds + RING_OFF);
            } else {
                for (int pi = vcu; pi < NB * NH * 8; pi += G) { const int bh = pi >> 3, s = pi & 7;
                    att::prompt_unit(bh / NH, bh % NH, s, Qb, Kb, Vb, Ob, sb_bias, lds + RING_OFF);
                    att::prompt_unit(bh / NH, bh % NH, 15 - s, Qb, Kb, Vb, Ob, sb_bias, lds + RING_OFF); }
            }
            __syncthreads();
            if (half == 0) { STAMPB(20); STAMPA(21); } else { STAMPB(21); STAMPB(24); }
        }
        if (BOTH(2)) GRID_BAR();
    }

    STAMP(3);
    if (IN(3)) {
        for (int id = gw; id < DB * NH * DS; id += NGW) {
            const int b = id / (NH * DS), h = (id / DS) % NH, i = id % DS;
            const size_t r0 = (size_t)(MP + b * DS);
            const float qd = bflo((unsigned)Qb[(r0 + i) * AW + h * HD + lane]);
            const float bias2 = sb_bias[h] * LOG2E;
            float carry = 1.0f, o = 0.f;
            for (int j = i - 1; j >= 0; --j) {
                const float kd = bflo((unsigned)Kb[(r0 + j) * AW + h * HD + lane]), vd = bflo((unsigned)Vb[(r0 + j) * AW + h * HD + lane]);
                const float z2 = wave_sum(qd * kd) + bias2;
                const float e = __builtin_amdgcn_exp2f(z2), w = __builtin_amdgcn_rcpf(1.0f + e);
                carry *= w; o += e * carry * vd;
            }
            const float* op = DPO + (((size_t)b * NH + h) * DCH * DS + i) * HD + lane; const float* wp = DPW + ((size_t)b * NH + h) * DCH * DS + i;
            float oc[DCH], wc_[DCH];
#pragma unroll
            for (int c = 0; c < DCH; ++c) { oc[c] = op[(size_t)c * DS * HD]; wc_[c] = wp[c * DS]; }
#pragma unroll
            for (int c = DCH - 1; c >= 0; --c) { o += carry * oc[c]; carry *= wc_[c]; }
            Ob[(r0 + i) * AW + h * HD + lane] = (bf16_t)(cvtpk(o, 0.f) & 0xffffu);
        }
        if (BOTH(3)) GRID_BAR();
    }

    STAMP(4);
    if (IN(4)) {
        pg8::StaticOrder S; S.init(MP, DM, G, bx);
        { pg8::Gemm g{Pb, Wpool_t, PW, 256, 256, 1, 256}; pg8::EpiPool E{SGB, pool_scale, MIX};
          pg8::gemm_phase<pg8::EpiPool, pg8::StaticOrder>(lds + RING_OFF, g, S, E); }
        { pg8::Gemm g{Ob, Wap_t, AW, AW, AW, 0, 0}; pg8::EpiProj E{SGA, MIX};
          pg8::gemm_phase<pg8::EpiProj, pg8::StaticOrder>(lds + RING_OFF, g, S, E); }
        { sk::SkPool SE1{SGB, pool_scale, MIX}; sk::SkProj SE2{SGA, MIX};
          for (int j = G - 1 - bx; j < DM / 64; j += G) {
              { const bf16_t* Bp = Wpool_t + (size_t)(64 * j) * 256; sk::unit<2>(lds + RING_OFF, Pb + (size_t)MP * PW + (j >> 3) * 256, PW, Bp, Bp + (size_t)32 * 256, 256, 256, SE1, j); }
              __syncthreads();
              { const bf16_t* Bp = Wap_t + (size_t)(64 * j) * AW; sk::unit<8>(lds + RING_OFF, Ob + (size_t)MP * AW, AW, Bp, Bp + (size_t)32 * AW, AW, AW, SE2, j); }
              __syncthreads(); } }
        if (BOTH(4)) GRID_BAR();
    }

    STAMP(5);
    if (IN(5)) {
        pg8::Gemm g{MIX, Wout_t, DM, DM, DM, 0, 0}; pg8::StaticOrder S; S.init(MP, DM, G, bx);
        pg8::EpiOut E{x_p, x_s, out, HB, SS};
        pg8::gemm_phase<pg8::EpiOut, pg8::StaticOrder>(lds + RING_OFF, g, S, E);
        { sk::SkOut SE{x_s, out, HB, SS};
          for (int j = G - 1 - bx; j < DM / 64; j += G) { const bf16_t* Bp = Wout_t + (size_t)(64 * j) * DM;
              sk::unit<8>(lds + RING_OFF, MIX + (size_t)MP * DM, DM, Bp, Bp + (size_t)32 * DM, DM, DM, SE, j); __syncthreads(); } }
        if (BOTH(5)) GRID_BAR();
    }

    STAMP(6);
    if (IN(6)) {
        pg8::Gemm g{HB, Wgu_t, DM, DM, DM, 0, 0}; pg8::StaticOrder S; S.init(MP, 2 * DFF, G, bx);
        pg8::EpiGU E{SS, ACT};
        pg8::gemm_phase<pg8::EpiGU, pg8::StaticOrder>(lds + RING_OFF, g, S, E);
        { sk::SkGU SE{SS, ACT};
          for (int j = G - 1 - bx; j < DFF / 32; j += G) { const bf16_t* Bp = Wgu_t + (size_t)(256 * (j >> 2) + 32 * (j & 3)) * DM;
              sk::unit<8>(lds + RING_OFF, HB + (size_t)MP * DM, DM, Bp, Bp + (size_t)128 * DM, DM, DM, SE, j); __syncthreads(); } }
        if (BOTH(6)) GRID_BAR();
    }

    STAMP(7);
    if (IN(7)) {
        pg8::Gemm g{ACT, Wd_t, DFF, DFF, DFF, 0, 0}; pg8::StaticOrder S; S.init(MP, DM, G, bx);
        pg8::EpiDown E{out};
        pg8::gemm_phase<pg8::EpiDown, pg8::StaticOrder>(lds + RING_OFF, g, S, E);
        { sk::SkDown SE{out};
          for (int j = G - 1 - bx; j < DM / 64; j += G) { const bf16_t* Bp = Wd_t + (size_t)(64 * j) * DFF;
              sk::unit<11>(lds + RING_OFF, ACT + (size_t)MP * DFF, DFF, Bp, Bp + (size_t)32 * DFF, DFF, DFF, SE, j); __syncthreads(); } }
    }
    if (PROBE_T == 7) GRID_BAR();
    STAMP(8);
    if (PROBE_T >= 0 && bx == PROBE_BLK && tid == 0) { const unsigned long long d = PROBE_T >= 20 ? (unsigned long long)__hip_atomic_load(ctl + CW_PROBE, __ATOMIC_RELAXED, __HIP_MEMORY_SCOPE_AGENT) : tk1 - tk0, t0 = __builtin_amdgcn_s_memrealtime(); while (__builtin_amdgcn_s_memrealtime() - t0 < d) __builtin_amdgcn_s_sleep(8); }
#undef IN
#undef BOTH
#undef GRID_BAR
#undef STAMP
}

extern "C" void kernel_launch(void* const* d_in, const int* in_sizes, int n_in, void* d_out, int out_size, void* d_ws, size_t ws_size, hipStream_t stream) {
    static int grid = 0;
    if (grid == 0) {
        if (n_in != 18 || (size_t)out_size != OUT_TOTAL || ws_size < WS_END) { fprintf(stderr, "kernel_launch: unexpected sizes (n_in %d, out %d, ws %zu)\n", n_in, out_size, ws_size); grid = -1; return; }
        int dev = 0, cus = 0, per_cu = 0;
        if (hipGetDevice(&dev) != hipSuccess || hipDeviceGetAttribute(&cus, hipDeviceAttributeMultiprocessorCount, dev) != hipSuccess) { grid = -1; return; }
        if (hipFuncSetAttribute((const void*)fwd_kernel, hipFuncAttributeMaxDynamicSharedMemorySize, LDS_BYTES) != hipSuccess) { fprintf(stderr, "kernel_launch: hipFuncSetAttribute failed\n"); grid = -1; return; }
        if (hipOccupancyMaxActiveBlocksPerMultiprocessor(&per_cu, (const void*)fwd_kernel, NWAVES * 64, LDS_BYTES) != hipSuccess || per_cu < 1)
            fprintf(stderr, "kernel_launch: occupancy query reports %d workgroups per CU\n", per_cu);
        (void)hipGetLastError();
        grid = cus;
    }
    if (grid < 0) return;
    if (hipMemsetAsync((char*)d_ws + WS_CTL, 0, CTL_ZERO_BYTES, stream) != hipSuccess) return;
    Args a{};
    for (int i = 0; i < 18; ++i) a.in[i] = d_in[i];
    a.out = (float*)d_out; a.ws = (unsigned char*)d_ws;
    if (PROBE_PH >= 0) {
        a.ph_lo = 0; a.ph_hi = PROBE_PH + 1; a.li = 0; hipLaunchKernelGGL(fwd_kernel, dim3(grid), dim3(NWAVES * 64), LDS_BYTES, stream, a);
        a.ph_lo = PROBE_PH; a.ph_hi = N_PHASES; a.li = 1; hipLaunchKernelGGL(fwd_kernel, dim3(grid), dim3(NWAVES * 64), LDS_BYTES, stream, a);
    } else if (MK_N_LAUNCHES == N_PHASES) {
        for (int li = 0; li < N_PHASES; ++li) { a.ph_lo = li; a.ph_hi = li + 1; a.li = 0; hipLaunchKernelGGL(fwd_kernel, dim3(grid), dim3(NWAVES * 64), LDS_BYTES, stream, a); }
    } else {
        a.ph_lo = 0; a.ph_hi = N_PHASES; a.li = 0;
        hipLaunchKernelGGL(fwd_kernel, dim3(grid), dim3(NWAVES * 64), LDS_BYTES, stream, a);
    }
}
```

```cpp
#include <hip/hip_runtime.h>
#include <cstdio>
#include <cstdint>

#define LAS __attribute__((address_space(3)))
#define GAS __attribute__((address_space(1)))
typedef unsigned short bf16_t;
typedef short bf16x8 __attribute__((ext_vector_type(8)));
typedef short s16x4 __attribute__((ext_vector_type(4)));
typedef float f32x2 __attribute__((ext_vector_type(2)));
typedef float f32x4 __attribute__((ext_vector_type(4)));
typedef float f32x16 __attribute__((ext_vector_type(16)));
typedef unsigned u32x2 __attribute__((ext_vector_type(2)));
typedef unsigned u32x4 __attribute__((ext_vector_type(4)));
typedef __bf16 bf16x2_t __attribute__((ext_vector_type(2)));

#ifndef MK_N_LAUNCHES
#define MK_N_LAUNCHES 1
#endif
#ifndef PROBE_T
#define PROBE_T -1
#endif
#ifndef PROBE_X
#define PROBE_X 0
#endif
#ifndef PROBE_BLK
#define PROBE_BLK 0
#endif
#ifndef PROBE_PH
#define PROBE_PH -1
#endif

constexpr int DM = 2048, NB = 2, SEQ = 4096, MP = NB * SEQ, DB = 8, DS = 4, MS = DB * DS, MR = MP + MS, MPAD = 8448;
constexpr int NH = 16, HD = 64, AW = 1024, PW = 1024, DFF = 5632, INC = 8192;
constexpr int PAST = 16384, PAGE = 128, NPG = PAST / PAGE, PSTATE = 15;
constexpr int DCH = 32;
constexpr float LOG2E = 1.4426950408889634f, C2 = 0.125f * LOG2E, EPS = 1e-6f;
constexpr size_t OFF_YP = 0, OFF_YS = (size_t)MP * DM, OFF_KP = OFF_YS + (size_t)MS * DM, OFF_VP = OFF_KP + (size_t)MP * AW, OFF_PP = OFF_VP + (size_t)MP * AW,
                 OFF_KS = OFF_PP + (size_t)NB * PSTATE * PW, OFF_VS = OFF_KS + (size_t)MS * AW, OFF_PS = OFF_VS + (size_t)MS * AW, OUT_TOTAL = OFF_PS + (size_t)DB * PSTATE * PW;

__device__ __forceinline__ unsigned cvtpk(float lo, float hi) { f32x2 v = {lo, hi}; bf16x2_t b = __builtin_convertvector(v, bf16x2_t); return __builtin_bit_cast(unsigned, b); }
__device__ __forceinline__ float bflo(unsigned u) { return __uint_as_float(u << 16); }
__device__ __forceinline__ float bfhi(unsigned u) { return __uint_as_float(u & 0xffff0000u); }
__device__ __forceinline__ u32x4 pack8(const f32x4 a, const f32x4 b) { u32x4 w; w.x = cvtpk(a[0], a[1]); w.y = cvtpk(a[2], a[3]); w.z = cvtpk(b[0], b[1]); w.w = cvtpk(b[2], b[3]); return w; }
__device__ __forceinline__ void unpack8(const u32x4 w, f32x4& a, f32x4& b) { a = (f32x4){bflo(w.x), bfhi(w.x), bflo(w.y), bfhi(w.y)}; b = (f32x4){bflo(w.z), bfhi(w.z), bflo(w.w), bfhi(w.w)}; }
__device__ __forceinline__ float sigm(float x) { return 1.0f / (1.0f + __expf(-x)); }

namespace pg8 {
constexpr int BM = 256, BK = 64, HALF = 128, HTB = HALF * BK * 2  , STAGE_BYTES = 8 * HTB, NXCD = 8, WGM = 8;
__host__ __device__ __forceinline__ int lds_byte(int r, int c) { const int st = (r >> 4) * 2 + (c >> 5), rr = r & 15, cc = c & 31, ob = rr * 64 + cc * 2; return st * 1024 + (ob ^ (((ob >> 9) & 1) << 5)); }
__host__ __device__ __forceinline__ void stage_rc(int b, int& R, int& C) { const int st = b / 1024, sb = b % 1024, swz = sb ^ (((sb >> 9) & 1) << 5); R = (st >> 1) * 16 + swz / 64; C = (st & 1) * 32 + (swz % 64) / 2; }
__host__ __device__ __forceinline__ int perm32(int rho) { const int n = rho >> 4, i = rho & 15; return 8 * (i >> 2) + 4 * n + (i & 3); }

struct Unit { int pm, pn; };
struct Gemm { const bf16_t* A; const bf16_t* Bt; int lda, ldb, K, agrp_shift, agrp_stride; };

struct StaticOrder {
    int nM, nN, nwg, G, c;
    __host__ __device__ void init(int M, int N, int G_, int c_) { nM = M / BM; nN = N / BM; nwg = nM * nN; G = G_; c = c_; }
    __host__ __device__ bool next(int i, Unit& u) const {
        const long L = (long)i * G + c; if (L >= nwg) return false;
        int wgid = (int)L; { const int q = nwg / NXCD, r = nwg % NXCD, xcd = wgid % NXCD, off = wgid / NXCD; wgid = (xcd < r ? xcd * (q + 1) : r * (q + 1) + (xcd - r) * q) + off; }
        const int nig = WGM * nN, gid = wgid / nig, fm = gid * WGM, gsz = (nM - fm) < WGM ? (nM - fm) : WGM;
        u.pm = fm + ((wgid % nig) % gsz); u.pn = (wgid % nig) / gsz; return true;
    }
    __device__ __forceinline__ void a_ready(const Unit&) const {}
    __device__ __forceinline__ void done(const Unit&) const {}
};

template <class Epi, class Sched>
__device__ __forceinline__ void gemm_phase(LAS unsigned char* lds, LAS unsigned char* ldsx, const Gemm g, const Sched& S, const Epi& E) {
    const int tid = threadIdx.x, wid = __builtin_amdgcn_readfirstlane(tid >> 6), lane = tid & 63, wr = wid >> 2, wc = wid & 3, fr = lane & 15, fq = lane >> 4;
    int nt = g.K / BK; asm volatile("" : "+s"(nt));
    unsigned voffA[2], voffB[2];
#pragma unroll
    for (int i = 0; i < 2; ++i) { int R, C; stage_rc(tid * 16 + i * 8192, R, C); const int Rb = Epi::PERM ? ((R & ~31) + perm32(R & 31)) : R;
        voffA[i] = (unsigned)(R * g.lda + C) * 2u; voffB[i] = (unsigned)(Rb * g.ldb + C) * 2u; }
    const size_t kstep = (size_t)(BK * 2);
    const size_t hstepA = (size_t)HALF * g.lda * 2, hstepB = (size_t)HALF * g.ldb * 2;
    const size_t tstepA = 2 * hstepA, tstepB = 2 * hstepB;
    const unsigned ldsw = (unsigned)wid * 1024u;
    const int aoff = lds_byte(wr * 64 + fr, fq * 8), boff = lds_byte(wc * 32 + fr, fq * 8);
#define PG8_SA(b, h) (((b) * 2 + (h)) * HTB)
#define PG8_SB(b, h) ((4 + (b) * 2 + (h)) * HTB)
#define PG8_STAGE(bufoff, gbase, voff) do { _Pragma("unroll") for (int _i = 0; _i < 2; ++_i) \
        __builtin_amdgcn_global_load_lds((const unsigned*)((const char*)(gbase) + (voff)[_i]), (LAS unsigned*)(lds + (bufoff) + ldsw + _i * 8192), 16, 0, 0); } while (0)
#define PG8_LDA(dst, b, h) do { _Pragma("unroll") for (int m = 0; m < 4; ++m) _Pragma("unroll") for (int k = 0; k < 2; ++k) dst[m][k] = *(const LAS bf16x8*)(lds + PG8_SA(b, h) + aoff + m * 2048 + k * 1024); } while (0)
#define PG8_LDB(dst, b, h) do { _Pragma("unroll") for (int n = 0; n < 2; ++n) _Pragma("unroll") for (int k = 0; k < 2; ++k) dst[n][k] = *(const LAS bf16x8*)(lds + PG8_SB(b, h) + boff + n * 2048 + k * 1024); } while (0)
#define PG8_MMA(ai, bj, At, Bt) do { __builtin_amdgcn_s_setprio(1); _Pragma("unroll") for (int m = 0; m < 4; ++m) _Pragma("unroll") for (int n = 0; n < 2; ++n) _Pragma("unroll") for (int k = 0; k < 2; ++k) \
        acc[ai][bj][m][n] = __builtin_amdgcn_mfma_f32_16x16x32_bf16(Bt[n][k], At[m][k], acc[ai][bj][m][n], 0, 0, 0); __builtin_amdgcn_s_setprio(0); } while (0)
#define PG8_WAIT_V(n) asm volatile("s_waitcnt vmcnt(" #n ")" ::: "memory")
#define PG8_WAIT_L(n) asm volatile("s_waitcnt lgkmcnt(" #n ")" ::: "memory")
#define PG8_BAR __builtin_amdgcn_s_barrier()
#define PG8_SCHED __builtin_amdgcn_sched_barrier(0)
#define PG8_ABASE(u) ((const char*)g.A + (size_t)(u).pm * tstepA + (size_t)(((u).pn >> g.agrp_shift) * g.agrp_stride) * 2)
    Unit cur, nxt; int ui = 0;
    if (!S.next(0, cur)) return;
    f32x4 acc[2][2][4][2];
#pragma unroll
    for (int a = 0; a < 2; ++a)
#pragma unroll
        for (int b = 0; b < 2; ++b)
#pragma unroll
            for (int m = 0; m < 4; ++m)
#pragma unroll
                for (int n = 0; n < 2; ++n) acc[a][b][m][n] = (f32x4){0.f, 0.f, 0.f, 0.f};
    bf16x8 At[4][2], B0[2][2], B1[2][2];
    const char* cA = PG8_ABASE(cur); const char* cB = (const char*)g.Bt + (size_t)cur.pn * tstepB;
    S.a_ready(cur);
    PG8_STAGE(PG8_SB(0, 0), cB, voffB); PG8_STAGE(PG8_SB(0, 1), cB + hstepB, voffB); PG8_STAGE(PG8_SA(0, 0), cA, voffA); PG8_STAGE(PG8_SA(0, 1), cA + hstepA, voffA);
    if (wr == 1) PG8_BAR;
    PG8_WAIT_V(2); PG8_BAR;
    PG8_STAGE(PG8_SB(1, 0), cB + kstep, voffB); PG8_STAGE(PG8_SA(1, 0), cA + kstep, voffA); PG8_STAGE(PG8_SB(1, 1), cB + hstepB + kstep, voffB);
    PG8_WAIT_V(6); PG8_BAR;
    for (;;) {
        const bool has_next = S.next(ui + 1, nxt);
        const char* nA = has_next ? PG8_ABASE(nxt) : cA; const char* nB = has_next ? (const char*)g.Bt + (size_t)nxt.pn * tstepB : cB;
        for (int t = 0; t < nt; t += 2) {
            const bool last = (t == nt - 2);
            const char* a1 = cA + (size_t)(t + 1) * kstep;
            const char* a2 = last ? nA : cA + (size_t)(t + 2) * kstep; const char* b2 = last ? nB : cB + (size_t)(t + 2) * kstep;
            const char* a3 = a2 + kstep; const char* b3 = b2 + kstep;
            if (last && has_next) S.a_ready(nxt);
            PG8_LDB(B0, 0, 0); PG8_LDB(B1, 0, 1); PG8_SCHED; PG8_LDA(At, 0, 0); PG8_STAGE(PG8_SA(1, 1), a1 + hstepA, voffA);
            PG8_WAIT_V(8); PG8_WAIT_L(0); PG8_BAR; PG8_MMA(0, 0, At, B0); PG8_MMA(0, 1, At, B1); PG8_BAR; PG8_SCHED;
            PG8_LDA(At, 0, 1); PG8_STAGE(PG8_SB(0, 0), b2, voffB); PG8_STAGE(PG8_SB(0, 1), b2 + hstepB, voffB); PG8_STAGE(PG8_SA(0, 0), a2, voffA);
            PG8_WAIT_V(8); PG8_WAIT_L(0); PG8_BAR; PG8_MMA(1, 0, At, B0); PG8_MMA(1, 1, At, B1); PG8_BAR; PG8_SCHED;
            PG8_LDB(B0, 1, 0); PG8_LDB(B1, 1, 1); PG8_SCHED; PG8_LDA(At, 1, 0); PG8_STAGE(PG8_SA(0, 1), a2 + hstepA, voffA);
            PG8_WAIT_V(8); PG8_WAIT_L(0); PG8_BAR; PG8_MMA(0, 0, At, B0); PG8_MMA(0, 1, At, B1); PG8_BAR; PG8_SCHED;
            PG8_LDA(At, 1, 1); PG8_STAGE(PG8_SB(1, 0), b3, voffB); PG8_STAGE(PG8_SB(1, 1), b3 + hstepB, voffB); PG8_STAGE(PG8_SA(1, 0), a3, voffA);
            PG8_WAIT_V(8); PG8_WAIT_L(0); PG8_BAR; PG8_MMA(1, 0, At, B0); PG8_MMA(1, 1, At, B1); PG8_BAR; PG8_SCHED;
        }
        if (wr == 0) PG8_BAR;
        E(acc, cur, wr, wc, fr, fq, ldsx); S.done(cur);
        if (!has_next) break;
#pragma unroll
        for (int a = 0; a < 2; ++a)
#pragma unroll
            for (int b = 0; b < 2; ++b)
#pragma unroll
                for (int m = 0; m < 4; ++m)
#pragma unroll
                    for (int n = 0; n < 2; ++n) acc[a][b][m][n] = (f32x4){0.f, 0.f, 0.f, 0.f};
        cur = nxt; cA = nA; cB = nB; ++ui;
        if (wr == 1) PG8_BAR;
    }
    PG8_WAIT_V(0);
    PG8_BAR;
#undef PG8_SA
#undef PG8_SB
#undef PG8_STAGE
#undef PG8_LDA
#undef PG8_LDB
#undef PG8_MMA
#undef PG8_WAIT_V
#undef PG8_WAIT_L
#undef PG8_BAR
#undef PG8_SCHED
#undef PG8_ABASE
}

#define EPI_ROWS_BEGIN _Pragma("unroll") for (int ai = 0; ai < 2; ++ai) _Pragma("unroll") for (int m = 0; m < 4; ++m) { \
        const int row0 = u.pm * BM + ai * HALF + wr * 64 + m * 16; if (row0 < MR) { const int row = row0 + fr;
#define EPI_ROWS_END } }

struct EpiIn {
    static constexpr bool PERM = true;
    bf16_t *Q, *Kb, *Vb, *SGA, *SGB; float* U; float* out; const float *qg, *kg;
    __device__ __forceinline__ void operator()(const f32x4 (&acc)[2][2][4][2], const Unit& u, int wr, int wc, int fr, int fq, LAS unsigned char*) const {
        const int kind = u.pn >> 2;
        EPI_ROWS_BEGIN
            if (kind <= 1) {
                float ss = 0.f;
#pragma unroll
                for (int bj = 0; bj < 2; ++bj)
#pragma unroll
                    for (int n = 0; n < 2; ++n) { const f32x4 x = acc[ai][bj][m][n]; ss += (x[0] * x[0] + x[1] * x[1]) + (x[2] * x[2] + x[3] * x[3]); }
                ss += __shfl_xor(ss, 16); ss += __shfl_xor(ss, 32);
                const float sc = rsqrtf(ss * (1.0f / 64.0f) + EPS) * (kind == 0 ? C2 : 1.0f);
                const float* g = kind == 0 ? qg : kg;
                const int head = (u.pn & 3) * 4 + wc;
                float* kn = row0 < MP ? out + OFF_KP + (size_t)row * AW : out + OFF_KS + (size_t)(row - MP) * AW;
#pragma unroll
                for (int bj = 0; bj < 2; ++bj) {
                    const int d0 = 32 * bj + 8 * fq, col = head * 64 + d0;
                    const f32x4 g0 = *(const f32x4*)(g + d0), g1 = *(const f32x4*)(g + d0 + 4);
                    const f32x4 v0 = acc[ai][bj][m][0] * sc * g0, v1 = acc[ai][bj][m][1] * sc * g1;
                    if (kind == 0) { *(u32x4*)(Q + (size_t)row * AW + col) = pack8(v0, v1); }
                    else { *(f32x4*)(kn + col) = v0; *(f32x4*)(kn + col + 4) = v1; *(u32x4*)(Kb + (size_t)row * AW + col) = pack8(v0, v1); }
                }
            } else if (kind == 2) {
                float* vn = row0 < MP ? out + OFF_VP + (size_t)row * AW : out + OFF_VS + (size_t)(row - MP) * AW;
#pragma unroll
                for (int bj = 0; bj < 2; ++bj) {
                    const int col = (u.pn - 8) * 256 + 64 * wc + 32 * bj + 8 * fq;
                    const f32x4 v0 = acc[ai][bj][m][0], v1 = acc[ai][bj][m][1];
                    *(f32x4*)(vn + col) = v0; *(f32x4*)(vn + col + 4) = v1; *(u32x4*)(Vb + (size_t)row * AW + col) = pack8(v0, v1);
                }
            } else if (kind == 3) {
#pragma unroll
                for (int bj = 0; bj < 2; ++bj) {
                    const int col = (u.pn - 12) * 256 + 64 * wc + 32 * bj + 8 * fq;
                    *(f32x4*)(U + (size_t)row * PW + col) = acc[ai][bj][m][0]; *(f32x4*)(U + (size_t)row * PW + col + 4) = acc[ai][bj][m][1];
                }
            } else {
                bf16_t* S = kind < 6 ? SGA : SGB;
                const int cb = (kind < 6 ? u.pn - 16 : u.pn - 24) * 256;
#pragma unroll
                for (int bj = 0; bj < 2; ++bj) {
                    const int col = cb + 64 * wc + 32 * bj + 8 * fq;
                    f32x4 v0 = acc[ai][bj][m][0], v1 = acc[ai][bj][m][1];
#pragma unroll
                    for (int e = 0; e < 4; ++e) { v0[e] = sigm(v0[e]); v1[e] = sigm(v1[e]); }
                    *(u32x4*)(S + (size_t)row * DM + col) = pack8(v0, v1);
                }
            }
        EPI_ROWS_END
    }
};
#define EPI_HALF_BEGIN _Pragma("unroll") for (int ai = 0; ai < 2; ++ai) {
#define EPI_HALF_END }
#define EPI_ROW(m) (u.pm * BM + ai * HALF + wr * 64 + (m) * 16 + fr)
struct EpiPool {
    static constexpr bool PERM = true;
    const bf16_t* SGB; const float* ps; bf16_t* MIX;
    __device__ __forceinline__ void operator()(const f32x4 (&acc)[2][2][4][2], const Unit& u, int wr, int wc, int fr, int fq, LAS unsigned char*) const {
        const int colb = u.pn * BM + wc * 32 + 8 * fq;
        EPI_HALF_BEGIN
            u32x4 sg[4][2];
#pragma unroll
            for (int m = 0; m < 4; ++m)
#pragma unroll
                for (int bj = 0; bj < 2; ++bj) sg[m][bj] = *(const u32x4*)(SGB + (size_t)EPI_ROW(m) * DM + colb + bj * HALF);
#pragma unroll
            for (int m = 0; m < 4; ++m)
#pragma unroll
                for (int bj = 0; bj < 2; ++bj) { const int col = colb + bj * HALF; f32x4 s0, s1; unpack8(sg[m][bj], s0, s1);
                    const f32x4 p0 = *(const f32x4*)(ps + col), p1 = *(const f32x4*)(ps + col + 4);
                    *(u32x4*)(MIX + (size_t)EPI_ROW(m) * DM + col) = pack8(acc[ai][bj][m][0] * p0 * s0, acc[ai][bj][m][1] * p1 * s1); }
        EPI_HALF_END
    }
};
struct EpiProj {
    static constexpr bool PERM = true;
    const bf16_t* SGA; bf16_t* MIX;
    __device__ __forceinline__ void operator()(const f32x4 (&acc)[2][2][4][2], const Unit& u, int wr, int wc, int fr, int fq, LAS unsigned char*) const {
        const int colb = u.pn * BM + wc * 32 + 8 * fq;
        EPI_HALF_BEGIN
            u32x4 sg[4][2], mx[4][2];
#pragma unroll
            for (int m = 0; m < 4; ++m)
#pragma unroll
                for (int bj = 0; bj < 2; ++bj) { sg[m][bj] = *(const u32x4*)(SGA + (size_t)EPI_ROW(m) * DM + colb + bj * HALF); mx[m][bj] = *(const u32x4*)(MIX + (size_t)EPI_ROW(m) * DM + colb + bj * HALF); }
#pragma unroll
            for (int m = 0; m < 4; ++m)
#pragma unroll
                for (int bj = 0; bj < 2; ++bj) { f32x4 s0, s1, q0, q1; unpack8(sg[m][bj], s0, s1); unpack8(mx[m][bj], q0, q1);
                    *(u32x4*)(MIX + (size_t)EPI_ROW(m) * DM + colb + bj * HALF) = pack8(acc[ai][bj][m][0] * s0 + q0, acc[ai][bj][m][1] * s1 + q1); }
        EPI_HALF_END
    }
};
struct EpiOut {
    static constexpr bool PERM = true;
    const float* xp; bf16_t* HB; float* SS;
    __device__ __forceinline__ void operator()(const f32x4 (&acc)[2][2][4][2], const Unit& u, int wr, int wc, int fr, int fq, LAS unsigned char*) const {
        const int colb = u.pn * BM + wc * 32 + 8 * fq;
        EPI_HALF_BEGIN
            f32x4 xv[4][2][2];
#pragma unroll
            for (int m = 0; m < 4; ++m)
#pragma unroll
                for (int bj = 0; bj < 2; ++bj) { const float* xr = xp + (size_t)EPI_ROW(m) * DM + colb + bj * HALF; xv[m][bj][0] = *(const f32x4*)xr; xv[m][bj][1] = *(const f32x4*)(xr + 4); }
#pragma unroll
            for (int m = 0; m < 4; ++m) { float ss = 0.f;
#pragma unroll
                for (int bj = 0; bj < 2; ++bj) { const f32x4 h0 = xv[m][bj][0] + acc[ai][bj][m][0], h1 = xv[m][bj][1] + acc[ai][bj][m][1];
                    *(u32x4*)(HB + (size_t)EPI_ROW(m) * DM + colb + bj * HALF) = pack8(h0, h1);
                    ss += (h0[0] * h0[0] + h0[1] * h0[1]) + (h0[2] * h0[2] + h0[3] * h0[3]) + (h1[0] * h1[0] + h1[1] * h1[1]) + (h1[2] * h1[2] + h1[3] * h1[3]); }
                ss += __shfl_xor(ss, 16); ss += __shfl_xor(ss, 32);
                if (fq == 0) SS[(size_t)EPI_ROW(m) * 32 + u.pn * 4 + wc] = ss; }
        EPI_HALF_END
    }
};
struct EpiGU {
    static constexpr bool PERM = true;
    const float* SS; bf16_t* ACT;
    __device__ __forceinline__ void operator()(const f32x4 (&acc)[2][2][4][2], const Unit& u, int wr, int wc, int fr, int fq, LAS unsigned char* ldsx) const {
        LAS float* tab = (LAS float*)ldsx;
        { const int t = threadIdx.x; const f32x4* sp = (const f32x4*)(SS + (size_t)(u.pm * BM + (t >> 1)) * 32 + (t & 1) * 16);
          const f32x4 a = sp[0], b = sp[1], c = sp[2], d = sp[3]; const f32x4 q = (a + b) + (c + d);
          float sm = (q[0] + q[1]) + (q[2] + q[3]); sm += __shfl_xor(sm, 1);
          if ((t & 1) == 0) tab[t >> 1] = rsqrtf(sm * (1.0f / DM) + EPS); }
        asm volatile("s_waitcnt lgkmcnt(0)" ::: "memory"); __builtin_amdgcn_s_barrier(); asm volatile("" ::: "memory");
        const int col = u.pn * HALF + wc * 32 + 8 * fq;
        EPI_HALF_BEGIN
#pragma unroll
            for (int m = 0; m < 4; ++m) { const float rstd = tab[ai * HALF + wr * 64 + m * 16 + fr];
                f32x4 a0, a1;
#pragma unroll
                for (int e = 0; e < 4; ++e) { const float g0 = acc[ai][0][m][0][e] * rstd, g1 = acc[ai][0][m][1][e] * rstd;
                    a0[e] = g0 * sigm(g0) * (acc[ai][1][m][0][e] * rstd); a1[e] = g1 * sigm(g1) * (acc[ai][1][m][1][e] * rstd); }
                *(u32x4*)(ACT + (size_t)EPI_ROW(m) * DFF + col) = pack8(a0, a1); }
        EPI_HALF_END
    }
};
struct EpiDown {
    static constexpr bool PERM = true;
    const bf16_t* HB; float* Y;
    __device__ __forceinline__ void operator()(const f32x4 (&acc)[2][2][4][2], const Unit& u, int wr, int wc, int fr, int fq, LAS unsigned char*) const {
        const int colb = u.pn * BM + wc * 32 + 8 * fq;
        EPI_HALF_BEGIN
            u32x4 hv[4][2];
#pragma unroll
            for (int m = 0; m < 4; ++m)
#pragma unroll
                for (int bj = 0; bj < 2; ++bj) hv[m][bj] = *(const u32x4*)(HB + (size_t)EPI_ROW(m) * DM + colb + bj * HALF);
#pragma unroll
            for (int m = 0; m < 4; ++m)
#pragma unroll
                for (int bj = 0; bj < 2; ++bj) { f32x4 h0, h1; unpack8(hv[m][bj], h0, h1); float* yp = Y + (size_t)EPI_ROW(m) * DM + colb + bj * HALF;
                    *(f32x4*)yp = h0 + acc[ai][bj][m][0]; *(f32x4*)(yp + 4) = h1 + acc[ai][bj][m][1]; }
        EPI_HALF_END
    }
};
struct EpiNull {
    static constexpr bool PERM = true;
    float* sink;
    __device__ __forceinline__ void operator()(const f32x4 (&acc)[2][2][4][2], const Unit& u, int wr, int wc, int fr, int fq, LAS unsigned char*) const {
        f32x4 t = (f32x4){0.f, 0.f, 0.f, 0.f};
#pragma unroll
        for (int ai = 0; ai < 2; ++ai)
#pragma unroll
            for (int bj = 0; bj < 2; ++bj)
#pragma unroll
                for (int m = 0; m < 4; ++m)
#pragma unroll
                    for (int n = 0; n < 2; ++n) t += acc[ai][bj][m][n];
        if (t[0] + t[1] + t[2] + t[3] == 123456.789f) sink[u.pm * 64 + fr] = t[0];
    }
};
}


namespace sk {
constexpr int PSTR = 68, PART_FLOATS = 32 * PSTR, RED_OFF = 8 * PART_FLOATS * 4;
template <int UNR, class Epi>
__device__ __forceinline__ void unit(LAS unsigned char* lds, const bf16_t* A, int lda, const bf16_t* B0, const bf16_t* B1, int ldb, int K, const Epi& E, int j) {
    const int tid = threadIdx.x, lane = tid & 63, r32 = lane & 31, hi = lane >> 5; const int wid = __builtin_amdgcn_readfirstlane(tid >> 6);
    const int kc = K >> 3;
    const bf16_t* ap = A + (size_t)r32 * lda + wid * kc + hi * 8;
    const bf16_t* b0 = B0 + (size_t)r32 * ldb + wid * kc + hi * 8;
    const bf16_t* b1 = B1 + (size_t)r32 * ldb + wid * kc + hi * 8;
    f32x16 acc0 = f32x16{}, acc1 = f32x16{};
    for (int k0 = 0; k0 < kc; k0 += 16 * UNR) {
        bf16x8 af[UNR], f0[UNR], f1[UNR];
#pragma unroll
        for (int i = 0; i < UNR; ++i) { af[i] = *(const bf16x8*)(ap + k0 + 16 * i); f0[i] = *(const bf16x8*)(b0 + k0 + 16 * i); f1[i] = *(const bf16x8*)(b1 + k0 + 16 * i); }
#pragma unroll
        for (int i = 0; i < UNR; ++i) { acc0 = __builtin_amdgcn_mfma_f32_32x32x16_bf16(f0[i], af[i], acc0, 0, 0, 0); acc1 = __builtin_amdgcn_mfma_f32_32x32x16_bf16(f1[i], af[i], acc1, 0, 0, 0); }
    }
    LAS float* part = (LAS float*)lds + wid * PART_FLOATS + r32 * PSTR + 4 * hi;
#pragma unroll
    for (int g = 0; g < 4; ++g) {
        *(LAS f32x4*)(part + 8 * g) = (f32x4){acc0[4 * g], acc0[4 * g + 1], acc0[4 * g + 2], acc0[4 * g + 3]};
        *(LAS f32x4*)(part + 32 + 8 * g) = (f32x4){acc1[4 * g], acc1[4 * g + 1], acc1[4 * g + 2], acc1[4 * g + 3]};
    }
    __syncthreads();
    { const int m = tid >> 4, c4 = (tid & 15) * 4; const LAS float* pp = (const LAS float*)lds + m * PSTR + c4;
      f32x4 t = *(const LAS f32x4*)pp;
#pragma unroll
      for (int w = 1; w < 8; ++w) t += *(const LAS f32x4*)(pp + w * PART_FLOATS);
      *(LAS f32x4*)((LAS float*)(lds + RED_OFF) + m * PSTR + c4) = t; }
    __syncthreads();
    E.run((const LAS float*)(lds + RED_OFF), j, tid);
}
__device__ __forceinline__ float sum16(float v) { v += __shfl_xor(v, 1); v += __shfl_xor(v, 2); v += __shfl_xor(v, 4); v += __shfl_xor(v, 8); return v; }
__device__ __forceinline__ u32x2 pack4(const f32x4 a) { return (u32x2){cvtpk(a[0], a[1]), cvtpk(a[2], a[3])}; }
__device__ __forceinline__ f32x4 unpack4(const u32x2 w) { return (f32x4){bflo(w.x), bfhi(w.x), bflo(w.y), bfhi(w.y)}; }
struct SkIn {
    bf16_t *Q, *Kb, *Vb, *SGA, *SGB; float* U; float* out; const float *qg, *kg;
    __device__ __forceinline__ void run(const LAS float* red, int j, int tid) const {
        const int m = tid >> 4, c4 = (tid & 15) * 4, kind = j >> 4; const size_t row = MP + m;
        f32x4 v = *(const LAS f32x4*)(red + m * PSTR + c4);
        if (kind <= 1) {
            const float ss = sum16((v[0] * v[0] + v[1] * v[1]) + (v[2] * v[2] + v[3] * v[3]));
            const float sc = rsqrtf(ss * (1.0f / 64.0f) + EPS) * (kind == 0 ? C2 : 1.0f);
            const f32x4 g = *(const f32x4*)((kind == 0 ? qg : kg) + c4);
            v = v * sc * g;
            const int col = (j & 15) * 64 + c4;
            if (kind == 0) *(u32x2*)(Q + row * AW + col) = pack4(v);
            else { *(f32x4*)(out + OFF_KS + (size_t)m * AW + col) = v; *(u32x2*)(Kb + row * AW + col) = pack4(v); }
        } else if (kind == 2) { const int col = (j - 32) * 64 + c4; *(f32x4*)(out + OFF_VS + (size_t)m * AW + col) = v; *(u32x2*)(Vb + row * AW + col) = pack4(v); }
        else if (kind == 3) { *(f32x4*)(U + row * PW + (j - 48) * 64 + c4) = v; }
        else { bf16_t* S = kind < 6 ? SGA : SGB; const int col = (kind < 6 ? j - 64 : j - 96) * 64 + c4;
#pragma unroll
            for (int e = 0; e < 4; ++e) v[e] = sigm(v[e]);
            *(u32x2*)(S + row * DM + col) = pack4(v); }
    }
};
struct SkPool {
    const bf16_t* SGB; const float* ps; bf16_t* MIX;
    __device__ __forceinline__ void run(const LAS float* red, int j, int tid) const {
        const int m = tid >> 4, c4 = (tid & 15) * 4, col = j * 64 + c4; const size_t row = MP + m;
        const f32x4 v = *(const LAS f32x4*)(red + m * PSTR + c4);
        *(u32x2*)(MIX + row * DM + col) = pack4(v * *(const f32x4*)(ps + col) * unpack4(*(const u32x2*)(SGB + row * DM + col)));
    }
};
struct SkProj {
    const bf16_t* SGA; bf16_t* MIX;
    __device__ __forceinline__ void run(const LAS float* red, int j, int tid) const {
        const int m = tid >> 4, c4 = (tid & 15) * 4, col = j * 64 + c4; const size_t row = MP + m;
        const f32x4 v = *(const LAS f32x4*)(red + m * PSTR + c4);
        *(u32x2*)(MIX + row * DM + col) = pack4(v * unpack4(*(const u32x2*)(SGA + row * DM + col)) + unpack4(*(const u32x2*)(MIX + row * DM + col)));
    }
};
struct SkOut {
    const float* xs; bf16_t* HB; float* SS;
    __device__ __forceinline__ void run(const LAS float* red, int j, int tid) const {
        const int m = tid >> 4, c4 = (tid & 15) * 4, col = j * 64 + c4; const size_t row = MP + m;
        const f32x4 h = *(const LAS f32x4*)(red + m * PSTR + c4) + *(const f32x4*)(xs + (size_t)m * DM + col);
        *(u32x2*)(HB + row * DM + col) = pack4(h);
        const float ss = sum16((h[0] * h[0] + h[1] * h[1]) + (h[2] * h[2] + h[3] * h[3]));
        if ((tid & 15) == 0) SS[row * 32 + j] = ss;
    }
};
struct SkGU {
    const float* SS; bf16_t* ACT;
    __device__ __forceinline__ void run(const LAS float* red, int j, int tid) const {
        if (tid < 256) {
            const int m = tid >> 3, i4 = (tid & 7) * 4; const size_t row = MP + m;
            const f32x4* sp = (const f32x4*)(SS + row * 32);
            f32x4 t = sp[0];
#pragma unroll
            for (int q = 1; q < 8; ++q) t += sp[q];
            const float rstd = rsqrtf(((t[0] + t[1]) + (t[2] + t[3])) * (1.0f / DM) + EPS);
            const f32x4 g = *(const LAS f32x4*)(red + m * PSTR + i4) * rstd, up = *(const LAS f32x4*)(red + m * PSTR + 32 + i4) * rstd;
            f32x4 a;
#pragma unroll
            for (int e = 0; e < 4; ++e) a[e] = g[e] * sigm(g[e]) * up[e];
            *(u32x2*)(ACT + row * DFF + j * 32 + i4) = pack4(a);
        }
    }
};
struct SkDown {
    const bf16_t* HB; float* Y;
    __device__ __forceinline__ void run(const LAS float* red, int j, int tid) const {
        const int m = tid >> 4, c4 = (tid & 15) * 4; const size_t off = (size_t)(MP + m) * DM + j * 64 + c4;
        *(f32x4*)(Y + off) = unpack4(*(const u32x2*)(HB + off)) + *(const LAS f32x4*)(red + m * PSTR + c4);
    }
};
}

namespace att {
typedef short v4i16_t __attribute__((ext_vector_type(4)));
typedef LAS const char* lds_cptr;
constexpr int LDS_K = 0, LDS_V = 16384, LDS_OST = 32768, LDS_BYTES = 65536;
__device__ __forceinline__ s16x4 vtr(lds_cptr p) { return __builtin_bit_cast(s16x4, __builtin_amdgcn_ds_read_tr16_b64_v4i16((LAS v4i16_t*)p)); }

template <int MODE>
__device__ __forceinline__ void sb_tile(f32x16 (&o)[2], float& carry, const bf16x8 (&qr)[4], lds_cptr kp, lds_cptr vp, const f32x16& bias16, int qrel, int hi) {
    f32x16 p0, p1;
#pragma unroll
    for (int d0 = 0; d0 < 4; ++d0) {
        const bf16x8 b0 = *(const LAS bf16x8*)(kp + d0 * 2048), b1 = *(const LAS bf16x8*)(kp + d0 * 2048 + 512);
        if (d0 == 0) { p0 = __builtin_amdgcn_mfma_f32_32x32x16_bf16(b0, qr[0], bias16, 0, 0, 0); p1 = __builtin_amdgcn_mfma_f32_32x32x16_bf16(b1, qr[0], bias16, 0, 0, 0); }
        else { p0 = __builtin_amdgcn_mfma_f32_32x32x16_bf16(b0, qr[d0], p0, 0, 0, 0); p1 = __builtin_amdgcn_mfma_f32_32x32x16_bf16(b1, qr[d0], p1, 0, 0, 0); }
    }
    if (MODE == 1) {
#pragma unroll
        for (int r = 0; r < 16; ++r) { const int kv = (r & 3) + 8 * (r >> 2) + 4 * hi; if (kv >= qrel) p0[r] = -INFINITY; if (kv + 32 >= qrel) p1[r] = -INFINITY; }
    }
    float e[32], G[8];
#pragma unroll
    for (int r = 0; r < 16; ++r) { e[r] = __builtin_amdgcn_exp2f(p0[r]); e[16 + r] = __builtin_amdgcn_exp2f(p1[r]); }
#pragma unroll
    for (int gi = 0; gi < 8; ++gi) {
        const float d0 = 1.0f + e[4 * gi], d1 = 1.0f + e[4 * gi + 1], d2 = 1.0f + e[4 * gi + 2], d3 = 1.0f + e[4 * gi + 3];
        const float pr2 = d0 * d1, pr3 = pr2 * d2;
        G[gi] = __builtin_amdgcn_rcpf(pr3 * d3);
        e[4 * gi + 1] *= d0; e[4 * gi + 2] *= pr2; e[4 * gi + 3] *= pr3;
    }
    float S = carry;
#pragma unroll
    for (int gi = 7; gi >= 0; --gi) {
        const auto rr = __builtin_amdgcn_permlane32_swap(__float_as_uint(G[gi]), __float_as_uint(G[gi]), false, false);
        const float Glo = __uint_as_float(rr[0]), Ghi = __uint_as_float(rr[1]);
        const float F = (hi ? S : S * Ghi) * G[gi];
#pragma unroll
        for (int j = 0; j < 4; ++j) e[4 * gi + j] *= F;
        S = S * (Glo * Ghi);
    }
    carry = S;
    bf16x8 pa[4];
#pragma unroll
    for (int ks = 0; ks < 4; ++ks) { u32x4 w; w.x = cvtpk(e[8 * ks], e[8 * ks + 1]); w.y = cvtpk(e[8 * ks + 2], e[8 * ks + 3]); w.z = cvtpk(e[8 * ks + 4], e[8 * ks + 5]); w.w = cvtpk(e[8 * ks + 6], e[8 * ks + 7]);
        pa[ks] = __builtin_bit_cast(bf16x8, w); }
#pragma unroll
    for (int dh = 0; dh < 2; ++dh)
#pragma unroll
        for (int ks = 0; ks < 4; ++ks) {
            const s16x4 lo = vtr(vp + dh * 4096 + ks * 1024), hi4 = vtr(vp + dh * 4096 + ks * 1024 + 512);
            const bf16x8 vf = (bf16x8){lo[0], lo[1], lo[2], lo[3], hi4[0], hi4[1], hi4[2], hi4[3]};
            o[dh] = __builtin_amdgcn_mfma_f32_32x32x16_bf16(pa[ks], vf, o[dh], 0, 0, 0);
        }
}

__device__ __forceinline__ void prompt_unit(int b, int h, int qb, const bf16_t* Q, const bf16_t* K, const bf16_t* V, bf16_t* O, const float* sbb, LAS unsigned char* lds) {
    const int tid = threadIdx.x, lane = tid & 63, r32 = lane & 31, hi = lane >> 5; const int wid = __builtin_amdgcn_readfirstlane(tid >> 6);
    const size_t rowbase = (size_t)b * SEQ; const int q0 = qb * 256;
    const bf16_t* Qw = Q + (rowbase + q0 + wid * 32) * AW + h * HD;
    const bf16_t* Kh = K + rowbase * AW + h * HD; const bf16_t* Vh = V + rowbase * AW + h * HD;
    const bf16_t* ksrc = Kh + (size_t)lane * AW + wid * 8;
    const bf16_t* vsrc = Vh + (size_t)(16 * (wid & 3) + (lane >> 2)) * AW + (wid >> 2) * 32 + (lane & 3) * 8;
    const lds_cptr l3 = (lds_cptr)lds;
    const lds_cptr kp0 = l3 + LDS_K + hi * 1024 + r32 * 16;
    const lds_cptr vp0 = l3 + LDS_V + ((lane >> 4) & 1) * 32 + (lane & 3) * 8 + (4 * hi + ((lane & 15) >> 2)) * 64;
#define ATT_DMA(t, slot) do { \
        __builtin_amdgcn_global_load_lds((const unsigned*)(ksrc + (size_t)(t) * 64 * AW), (LAS unsigned*)(lds + LDS_K + (slot) * 8192 + wid * 1024), 16, 0, 0); \
        __builtin_amdgcn_global_load_lds((const unsigned*)(vsrc + (size_t)(t) * 64 * AW), (LAS unsigned*)(lds + LDS_V + (slot) * 8192 + wid * 1024), 16, 0, 0); } while (0)
    const int NT = (q0 + 256) / 64;
    ATT_DMA(NT - 1, 0);
    bf16x8 qr[4];
#pragma unroll
    for (int d0 = 0; d0 < 4; ++d0) qr[d0] = *(const bf16x8*)(Qw + (size_t)r32 * AW + d0 * 16 + hi * 8);
    const float bias2 = sbb[h] * LOG2E;
    f32x16 bias16;
#pragma unroll
    for (int r = 0; r < 16; ++r) bias16[r] = bias2;
    f32x16 o[2]; o[0] = f32x16{}; o[1] = f32x16{};
    float carry = 1.0f;
    asm volatile("s_waitcnt vmcnt(0)" ::: "memory"); __builtin_amdgcn_s_barrier();
    int slot = 0;
    for (int t = NT - 1; t >= 0; --t) {
        if (t > 0) ATT_DMA(t - 1, slot ^ 1);
        const int qmin = q0 + wid * 32 - 64 * t;
        if (qmin + 31 > 0) {
            if (qmin >= 64) sb_tile<0>(o, carry, qr, kp0 + slot * 8192, vp0 + slot * 8192, bias16, 0, hi);
            else sb_tile<1>(o, carry, qr, kp0 + slot * 8192, vp0 + slot * 8192, bias16, qmin + r32, hi);
        }
        asm volatile("s_waitcnt vmcnt(0) lgkmcnt(0)" ::: "memory"); __builtin_amdgcn_s_barrier();
        slot ^= 1;
    }
#undef ATT_DMA
    LAS bf16_t* stg = (LAS bf16_t*)(lds + LDS_OST) + wid * 2048;
#pragma unroll
    for (int r = 0; r < 16; ++r) { const int orow = (r & 3) + 8 * (r >> 2) + 4 * hi;
#pragma unroll
        for (int dh = 0; dh < 2; ++dh) stg[orow * 64 + dh * 32 + r32] = (bf16_t)(cvtpk(o[dh][r], 0.f) & 0xffffu); }
    asm volatile("s_waitcnt lgkmcnt(0)" ::: "memory");
    bf16_t* Ow = O + (rowbase + q0 + wid * 32) * AW + h * HD;
#pragma unroll
    for (int i = 0; i < 4; ++i) { const int row = i * 8 + (lane >> 3), ch = lane & 7; const u32x4 v = *(const LAS u32x4*)(stg + row * 64 + ch * 8); *(u32x4*)(Ow + (size_t)row * AW + ch * 8) = v; }
    asm volatile("s_waitcnt lgkmcnt(0)" ::: "memory"); __builtin_amdgcn_s_barrier();
}

__device__ __forceinline__ void decode_unit(int b, int c, const bf16_t* Q, const float* ck, const float* cv, const int* pt, const float* sbb, float* DPO, float* DPW, LAS unsigned char* lds) {
    const int tid = threadIdx.x, lane = tid & 63, r32 = lane & 31, hi = lane >> 5; const int wid = __builtin_amdgcn_readfirstlane(tid >> 6);
    LAS unsigned char* wl = lds + wid * 16384;
    const lds_cptr kp0 = (lds_cptr)wl + hi * 1024 + r32 * 16;
    const lds_cptr vp0 = (lds_cptr)wl + 8192 + ((lane >> 4) & 1) * 32 + (lane & 3) * 8 + (4 * hi + ((lane & 15) >> 2)) * 64;
    const int tk = lane >> 4, d4 = (lane & 15) * 4;
    LAS unsigned char* kw = wl + (d4 >> 3) * 1024 + (d4 & 7) * 2;
    LAS unsigned char* vw = wl + 8192 + (d4 >> 5) * 4096 + (d4 & 31) * 2;
    for (int hh = 0; hh < 2; ++hh) {
        const int h = 2 * wid + hh;
        bf16x8 qr[4];
#pragma unroll
        for (int d0 = 0; d0 < 4; ++d0) { qr[d0] = (bf16x8){0, 0, 0, 0, 0, 0, 0, 0}; if (r32 < DS) qr[d0] = *(const bf16x8*)(Q + (size_t)(MP + b * DS + r32) * AW + h * HD + d0 * 16 + hi * 8); }
        const float bias2 = sbb[h] * LOG2E;
        f32x16 bias16;
#pragma unroll
        for (int r = 0; r < 16; ++r) bias16[r] = bias2;
        f32x16 o[2]; o[0] = f32x16{}; o[1] = f32x16{};
        float carry = 1.0f;
        for (int tt = 7; tt >= 0; --tt) {
            const int page = pt[b * NPG + c * 4 + (tt >> 1)];
            const size_t tok0 = (size_t)page * PAGE + (tt & 1) * 64;
            const float* kb = ck + ((tok0 + tk) * NH + h) * HD + d4;
            const float* vb = cv + ((tok0 + tk) * NH + h) * HD + d4;
            f32x4 kr[16];
#pragma unroll
            for (int i = 0; i < 16; ++i) kr[i] = __builtin_nontemporal_load((const f32x4*)(kb + (size_t)i * 4 * NH * HD));
#pragma unroll
            for (int i = 0; i < 16; ++i) { u32x2 w; w.x = cvtpk(kr[i][0], kr[i][1]); w.y = cvtpk(kr[i][2], kr[i][3]); *(LAS u32x2*)(kw + (4 * i + tk) * 16) = w; }
#pragma unroll
            for (int i = 0; i < 16; ++i) kr[i] = __builtin_nontemporal_load((const f32x4*)(vb + (size_t)i * 4 * NH * HD));
#pragma unroll
            for (int i = 0; i < 16; ++i) { u32x2 w; w.x = cvtpk(kr[i][0], kr[i][1]); w.y = cvtpk(kr[i][2], kr[i][3]); *(LAS u32x2*)(vw + (4 * i + tk) * 64) = w; }
            asm volatile("s_waitcnt lgkmcnt(0)" ::: "memory");
            sb_tile<0>(o, carry, qr, kp0, vp0, bias16, 0, hi);
            asm volatile("s_waitcnt lgkmcnt(0)" ::: "memory");
        }
        if (hi == 0) {
            float* op = DPO + ((((size_t)b * NH + h) * DCH + c) * DS) * HD;
#pragma unroll
            for (int q = 0; q < DS; ++q)
#pragma unroll
                for (int dh = 0; dh < 2; ++dh) op[q * HD + dh * 32 + r32] = o[dh][q];
            if (r32 < DS) DPW[(((size_t)b * NH + h) * DCH + c) * DS + r32] = carry;
        }
    }
}
}

constexpr int NWAVES = 8;
constexpr int N_PHASES = 8;
constexpr size_t MiB = 1u << 20;
constexpr size_t WS_CTL = 0, CTL_ZERO_BYTES = 1 * MiB;
constexpr size_t WS_WIN = 2 * MiB, WS_WAP = 34 * MiB, WS_WPOOL = 38 * MiB, WS_WOUT = 40 * MiB, WS_WGU = 48 * MiB, WS_WD = 92 * MiB;
constexpr size_t WS_XN = 114 * MiB, WS_Q = 148 * MiB, WS_K = 165 * MiB, WS_V = 182 * MiB, WS_U = 199 * MiB, WS_SGA = 232 * MiB, WS_SGB = 265 * MiB;
constexpr size_t WS_P = 298 * MiB, WS_O = 315 * MiB, WS_MIX = 332 * MiB, WS_HB = 365 * MiB, WS_SS = 398 * MiB, WS_ACT = 400 * MiB, WS_DPO = 491 * MiB, WS_DPW = 495 * MiB, WS_END = 496 * MiB;
static_assert(WS_WIN + (size_t)INC * DM * 2 <= WS_WAP && WS_WAP + (size_t)DM * AW * 2 <= WS_WPOOL && WS_WPOOL + (size_t)DM * 256 * 2 <= WS_WOUT && WS_WOUT + (size_t)DM * DM * 2 <= WS_WGU &&
              WS_WGU + (size_t)2 * DFF * DM * 2 <= WS_WD && WS_WD + (size_t)DM * DFF * 2 <= WS_XN && WS_XN + (size_t)MPAD * DM * 2 <= WS_Q && WS_Q + (size_t)MPAD * AW * 2 <= WS_K &&
              WS_K + (size_t)MPAD * AW * 2 <= WS_V && WS_V + (size_t)MPAD * AW * 2 <= WS_U && WS_U + (size_t)MPAD * PW * 4 <= WS_SGA && WS_SGA + (size_t)MPAD * DM * 2 <= WS_SGB &&
              WS_SGB + (size_t)MPAD * DM * 2 <= WS_P && WS_P + (size_t)MPAD * PW * 2 <= WS_O && WS_O + (size_t)MPAD * AW * 2 <= WS_MIX && WS_MIX + (size_t)MPAD * DM * 2 <= WS_HB &&
              WS_HB + (size_t)MPAD * DM * 2 <= WS_SS && WS_SS + (size_t)MPAD * 32 * 4 <= WS_ACT && WS_ACT + (size_t)MPAD * DFF * 2 <= WS_DPO &&
              WS_DPO + (size_t)DB * NH * DCH * DS * HD * 4 <= WS_DPW && WS_DPW + (size_t)DB * NH * DCH * DS * 4 <= WS_END, "d_ws map");
constexpr int CW_TMO = 0, CW_PROBE = 64, CW_BAR = 4096;
constexpr int RING_OFF = 0, RING_BYTES = 131072;
constexpr int LDSCTL_OFF = RING_BYTES, MISC_OFF = LDSCTL_OFF + 320, EPIX_OFF = LDSCTL_OFF + 1024;
constexpr int LDS_BYTES = 147456;

typedef GAS unsigned gu32;
#define RLX_AGENT __ATOMIC_RELAXED, __HIP_MEMORY_SCOPE_AGENT
#define LDS_WAIT() asm volatile("s_waitcnt lgkmcnt(0)" ::: "memory")

#define XB_TMO      128
#define XB_XCNT(j)  (256  + 64 * (j))
#define XB_XSUB(j)  (1280 + 64 * (j))
#define XB_XGEN(j)  (2304 + 64 * (j))
#define XB_TOP      3328
#define XB_TOPGEN   3392
#define XCD_BAR_WORDS 3456
#define XB_SPIN_CAP (1u << 18)
__device__ __forceinline__ unsigned xb_ld(unsigned* p)              { return __hip_atomic_load(p, __ATOMIC_RELAXED, __HIP_MEMORY_SCOPE_AGENT); }
__device__ __forceinline__ unsigned xb_add(unsigned* p, unsigned v) { return __hip_atomic_fetch_add(p, v, __ATOMIC_RELAXED, __HIP_MEMORY_SCOPE_AGENT); }
__device__ __forceinline__ unsigned xb_xcc_id() { return (unsigned)__builtin_amdgcn_s_getreg((3 << 11) | 20) & 0xFu; }
#define XB_SPIN(cond, bar) do { unsigned _sp = 0; while (cond) { __builtin_amdgcn_s_sleep(1); \
    if ((++_sp & 255u) == 0u) { if (xb_ld(&(bar)[XB_TMO])) break; if (_sp > XB_SPIN_CAP) { atomicAdd(&(bar)[XB_TMO], 1u); break; } } } } while (0)
struct XcdBarrier { unsigned* bar; unsigned x; volatile LAS unsigned* st; };
__device__ __forceinline__ XcdBarrier xcd_barrier_post(unsigned* bar, volatile LAS unsigned* st) {
    XcdBarrier b; b.bar = bar; b.x = xb_xcc_id(); b.st = st;
    if (threadIdx.x == 0) (void)xb_add(&bar[XB_XCNT(b.x)], 1u);
    return b;
}
__device__ __forceinline__ void xcd_barrier_complete(unsigned* bar, unsigned x, unsigned& nloc, unsigned& nx) {
    const unsigned G = gridDim.x * gridDim.y * gridDim.z;
    unsigned sum, cnt, mine, sp = 0u;
    for (;;) {
        sum = 0u; cnt = 0u; mine = 0u;
#pragma unroll
        for (unsigned j = 0; j < 16; ++j) { const unsigned c = xb_ld(&bar[XB_XCNT(j)]); sum += c; cnt += (c > 0u) ? 1u : 0u; mine = (j == x) ? c : mine; }
        if (sum == G) break;
        __builtin_amdgcn_s_sleep(1);
        if ((++sp & 255u) == 0u) { if (xb_ld(&bar[XB_TMO])) break; if (sp > XB_SPIN_CAP) { atomicAdd(&bar[XB_TMO], 1u); break; } }
    }
    nloc = mine > 0u ? mine : 1u; nx = cnt > 0u ? cnt : 1u;
}
__device__ __forceinline__ void xcd_barrier(const XcdBarrier& b) {
    asm volatile("s_waitcnt vmcnt(0)" ::: "memory");
    __syncthreads();
    if (threadIdx.x == 0) {
        unsigned* bar = b.bar;
        __builtin_amdgcn_s_waitcnt(0);
        unsigned nloc = b.st[0], nx = b.st[1];
        if (nloc == 0u) { xcd_barrier_complete(bar, b.x, nloc, nx); b.st[0] = nloc; b.st[1] = nx; }
        const unsigned old = xb_add(&bar[XB_XSUB(b.x)], 1u);
        const unsigned gen = old / nloc;
        if (old + 1u == (gen + 1u) * nloc) {
            __builtin_amdgcn_fence(__ATOMIC_RELEASE, "agent");
            asm volatile("s_waitcnt vmcnt(0)" ::: "memory");
            const unsigned og = xb_add(&bar[XB_TOP], 1u);
            const unsigned tg = og / nx;
            if (og + 1u == (tg + 1u) * nx) xb_add(&bar[XB_TOPGEN], 1u);
            else XB_SPIN(xb_ld(&bar[XB_TOPGEN]) == tg, bar);
            __builtin_amdgcn_fence(__ATOMIC_ACQUIRE, "agent");
            xb_add(&bar[XB_XGEN(b.x)], 1u);
            asm volatile("s_waitcnt vmcnt(0)" ::: "memory");
        } else {
            XB_SPIN(xb_ld(&bar[XB_XGEN(b.x)]) == gen, bar);
            __builtin_amdgcn_fence(__ATOMIC_ACQUIRE, "agent");
            asm volatile("s_waitcnt vmcnt(0)" ::: "memory");
        }
    }
    __syncthreads();
}

__device__ __forceinline__ float wave_sum(float v) {
#pragma unroll
    for (int o = 1; o < 64; o <<= 1) v += __shfl_xor(v, o);
    return v;
}

struct TItem { const float* src; bf16_t* dst; const float* ksc; int ldn, ldk; };
__device__ __forceinline__ void p0_item_load(const TItem& d, f32x4 (&v)[8], int lane) {
#pragma unroll
    for (int i = 0; i < 8; ++i) v[i] = __builtin_nontemporal_load((const f32x4*)(d.src + (size_t)(8 * i + (lane >> 3)) * d.ldn + 4 * (lane & 7)));
}
__device__ __forceinline__ void p0_item_store(const TItem& d, const f32x4 (&v)[8], LAS float* scr, int lane) {
#pragma unroll
    for (int i = 0; i < 8; ++i) { const int kk = 8 * i + (lane >> 3); f32x4 x = v[i]; if (d.ksc) x *= d.ksc[kk]; LAS float* q = scr + kk * 33 + 4 * (lane & 7); q[0] = x[0]; q[1] = x[1]; q[2] = x[2]; q[3] = x[3]; }
    LDS_WAIT(); asm volatile("" ::: "memory");
    const int c = lane & 7;
#pragma unroll
    for (int j = 0; j < 4; ++j) { const int n = (lane >> 3) + 8 * j; const LAS float* s = scr + (8 * c) * 33 + n;
        u32x4 o; o.x = cvtpk(s[0 * 33], s[1 * 33]); o.y = cvtpk(s[2 * 33], s[3 * 33]); o.z = cvtpk(s[4 * 33], s[5 * 33]); o.w = cvtpk(s[6 * 33], s[7 * 33]);
        *(u32x4*)(d.dst + (size_t)n * d.ldk + 8 * c) = o; }
    LDS_WAIT(); asm volatile("" ::: "memory");
}

struct Args { const void* in[18]; float* out; unsigned char* ws; int ph_lo, ph_hi, li, pad; };

__global__ void __launch_bounds__(NWAVES * 64, 2) fwd_kernel(Args args) {
    extern __shared__ __attribute__((aligned(16))) unsigned char lds_raw[];
    LAS unsigned char* lds = (LAS unsigned char*)lds_raw;
    volatile LAS unsigned* MISC = (volatile LAS unsigned*)(lds + MISC_OFF);
    const int tid = threadIdx.x, lane = tid & 63, wave = __builtin_amdgcn_readfirstlane(tid >> 6);
    const int G = gridDim.x; const int bx = blockIdx.x; const int vcu = (G % 8 == 0) ? (bx % 8) * (G / 8) + bx / 8 : bx;
    const int gw = vcu * NWAVES + wave, NGW = G * NWAVES;
    unsigned char* ws = args.ws;
    unsigned* ctl = (unsigned*)(ws + WS_CTL);
    const float* x_p = (const float*)args.in[0]; const float* x_s = (const float*)args.in[1];
    const float* cache_k = (const float*)args.in[2]; const float* cache_v = (const float*)args.in[3];
    const float* state_pool = (const float*)args.in[4]; const int* page_table = (const int*)args.in[5];
    const float* norm1_g = (const float*)args.in[6]; const float* w_in = (const float*)args.in[7];
    const float* q_g = (const float*)args.in[8]; const float* k_g = (const float*)args.in[9]; const float* sb_bias = (const float*)args.in[10];
    const float* w_ap = (const float*)args.in[11]; const float* w_pool = (const float*)args.in[12]; const float* pool_scale = (const float*)args.in[13];
    const float* w_out = (const float*)args.in[14]; const float* norm2_g = (const float*)args.in[15]; const float* w_gu = (const float*)args.in[16]; const float* w_down = (const float*)args.in[17];
    float* out = args.out;
    bf16_t* Win_t = (bf16_t*)(ws + WS_WIN); bf16_t* Wap_t = (bf16_t*)(ws + WS_WAP); bf16_t* Wpool_t = (bf16_t*)(ws + WS_WPOOL); bf16_t* Wout_t = (bf16_t*)(ws + WS_WOUT);
    bf16_t* Wgu_t = (bf16_t*)(ws + WS_WGU); bf16_t* Wd_t = (bf16_t*)(ws + WS_WD);
    bf16_t* XN = (bf16_t*)(ws + WS_XN); bf16_t* Qb = (bf16_t*)(ws + WS_Q); bf16_t* Kb = (bf16_t*)(ws + WS_K); bf16_t* Vb = (bf16_t*)(ws + WS_V);
    float* U = (float*)(ws + WS_U); bf16_t* SGA = (bf16_t*)(ws + WS_SGA); bf16_t* SGB = (bf16_t*)(ws + WS_SGB); bf16_t* Pb = (bf16_t*)(ws + WS_P); bf16_t* Ob = (bf16_t*)(ws + WS_O);
    bf16_t* MIX = (bf16_t*)(ws + WS_MIX); bf16_t* HB = (bf16_t*)(ws + WS_HB); float* SS = (float*)(ws + WS_SS); bf16_t* ACT = (bf16_t*)(ws + WS_ACT);
    float* DPO = (float*)(ws + WS_DPO); float* DPW = (float*)(ws + WS_DPW);

    unsigned long long tk0 = 0ull, tk1 = 0ull;
    if (PROBE_T == 100 && blockIdx.x == PROBE_BLK && threadIdx.x == 0) tk0 = __builtin_amdgcn_s_memrealtime();
    for (int u = tid; u < (LDS_BYTES - LDSCTL_OFF) / 4; u += NWAVES * 64) ((LAS unsigned*)(lds + LDSCTL_OFF))[u] = 0u;
    __syncthreads();
    XcdBarrier bar; bar.bar = ctl + CW_BAR + args.li * XCD_BAR_WORDS; bar.x = 0; bar.st = nullptr;
    if (MK_N_LAUNCHES != N_PHASES) bar = xcd_barrier_post(ctl + CW_BAR + args.li * XCD_BAR_WORDS, MISC + 8);
    const int lo = args.ph_lo, hi_ph = args.ph_hi;
#define IN(k) (lo <= (k) && (k) < hi_ph)
#define BOTH(k) (IN(k) && IN((k) + 1))
#define GRID_BAR() do { if (MK_N_LAUNCHES != N_PHASES) xcd_barrier(bar); } while (0)
#define STAMPA(id) do { if (PROBE_T == (id) && tid == 0) tk0 = __builtin_amdgcn_s_memrealtime(); } while (0)
#define STAMPB(id) do { if (PROBE_T == (id) && tid == 0) atomicMax(ctl + CW_PROBE, (unsigned)(__builtin_amdgcn_s_memrealtime() - tk0)); } while (0)
#define STAMP(k) do { if (PROBE_T >= 0 && bx == PROBE_BLK && tid == 0) { if ((k) == PROBE_T) tk0 = __builtin_amdgcn_s_memrealtime(); if ((k) == PROBE_T + 1) tk1 = __builtin_amdgcn_s_memrealtime(); } } while (0)

    STAMP(0);
    if (IN(0)) {
        LAS float* scr = (LAS float*)(lds + RING_OFF + wave * 16384);
        constexpr int I_IN = (DM / 64) * (INC / 32), I_AP = (AW / 64) * (DM / 32), I_PL = 4 * (256 / 64) * (512 / 32), I_OUT = (DM / 64) * (DM / 32), I_GU = (DM / 64) * (2 * DFF / 32), I_DN = (DFF / 64) * (DM / 32);
        constexpr int NITEMS = I_IN + I_AP + I_PL + I_OUT + I_GU + I_DN;
        auto desc = [&](int it) -> TItem {
            int r = it;
            if (r < I_IN) { const int nblk = INC / 32, kb = r / nblk, nb = r % nblk, P0 = 32 * nb, pn = P0 >> 8, bj = (P0 >> 7) & 1, wc = (P0 >> 5) & 3, n0 = 256 * pn + 64 * wc + 32 * bj;
                return TItem{w_in + (size_t)(64 * kb) * INC + n0, Win_t + (size_t)P0 * DM + 64 * kb, nullptr, INC, DM}; } r -= I_IN;
            if (r < I_AP) { const int nblk = DM / 32, kb = r / nblk, nb = r % nblk;
                return TItem{w_ap + (size_t)(64 * kb) * DM + 32 * nb, Wap_t + (size_t)(32 * nb) * AW + 64 * kb, nullptr, DM, AW}; } r -= I_AP;
            if (r < I_PL) { const int gp = r / 64, r2 = r % 64, kb = r2 / 16, nb = r2 % 16;
                return TItem{w_pool + (size_t)gp * 256 * 512 + (size_t)(64 * kb) * 512 + 32 * nb, Wpool_t + (size_t)(512 * gp + 32 * nb) * 256 + 64 * kb, nullptr, 512, 256}; } r -= I_PL;
            if (r < I_OUT) { const int nblk = DM / 32, kb = r / nblk, nb = r % nblk;
                return TItem{w_out + (size_t)(64 * kb) * DM + 32 * nb, Wout_t + (size_t)(32 * nb) * DM + 64 * kb, nullptr, DM, DM}; } r -= I_OUT;
            if (r < I_GU) { const int nblk = 2 * DFF / 32, kb = r / nblk, nb = r % nblk, P0 = 32 * nb, pn = P0 >> 8, bj = (P0 >> 7) & 1, i0 = P0 & 127, n0 = bj * DFF + 128 * pn + i0;
                return TItem{w_gu + (size_t)(64 * kb) * (2 * DFF) + n0, Wgu_t + (size_t)P0 * DM + 64 * kb, norm2_g + 64 * kb, 2 * DFF, DM}; } r -= I_GU;
            { const int nblk = DM / 32, kb = r / nblk, nb = r % nblk;
                return TItem{w_down + (size_t)(64 * kb) * DM + 32 * nb, Wd_t + (size_t)(32 * nb) * DFF + 64 * kb, nullptr, DM, DFF}; }
        };
        if (gw < NITEMS) {
            TItem cur = desc(gw); f32x4 v[8]; p0_item_load(cur, v, lane);
            for (int it = gw; it < NITEMS; it += NGW) {
                const int nx = it + NGW; TItem nd = cur; f32x4 vn[8];
                if (nx < NITEMS) { nd = desc(nx); p0_item_load(nd, vn, lane); }
                p0_item_store(cur, v, scr, lane);
                cur = nd;
#pragma unroll
                for (int i = 0; i < 8; ++i) v[i] = vn[i];
            }
        }
        for (int mrow = gw; mrow < MR; mrow += NGW) {
            unsigned long long* o8 = (unsigned long long*)(XN + (size_t)mrow * DM) + lane;
            if (mrow < MR) {
                const float* xrow = mrow < MP ? x_p + (size_t)mrow * DM : x_s + (size_t)(mrow - MP) * DM;
                const f32x4* xr = (const f32x4*)xrow + lane;
                f32x4 v[8]; float s = 0.f;
#pragma unroll
                for (int j = 0; j < 8; ++j) { v[j] = xr[64 * j]; s += (v[j][0] * v[j][0] + v[j][1] * v[j][1]) + (v[j][2] * v[j][2] + v[j][3] * v[j][3]); }
                const float rstd = rsqrtf(wave_sum(s) * (1.0f / DM) + EPS);
#pragma unroll
                for (int j = 0; j < 8; ++j) { const f32x4 gg = *((const f32x4*)norm1_g + lane + 64 * j); const f32x4 y = v[j] * rstd * gg;
                    o8[64 * j] = (unsigned long long)cvtpk(y[0], y[1]) | ((unsigned long long)cvtpk(y[2], y[3]) << 32); }
            } else {
#pragma unroll
                for (int j = 0; j < 8; ++j) o8[64 * j] = 0ull;
            }
        }
        if (BOTH(0)) GRID_BAR();
    }

    STAMP(1);
    if (IN(1)) {
        pg8::Gemm g{XN, Win_t, DM, DM, DM, 0, 0}; pg8::StaticOrder S; S.init(MP, INC, G, bx);
        pg8::EpiIn E{Qb, Kb, Vb, SGA, SGB, U, out, q_g, k_g};
        { sk::SkIn SE{Qb, Kb, Vb, SGA, SGB, U, out, q_g, k_g};
          for (int j = G - 1 - bx; j < INC / 64; j += G) { const bf16_t* Bp = Win_t + (size_t)(256 * (j >> 2) + 32 * (j & 3)) * DM;
              sk::unit<8>(lds + RING_OFF, XN + (size_t)MP * DM, DM, Bp, Bp + (size_t)128 * DM, DM, DM, SE, j); __syncthreads(); } }
        pg8::gemm_phase<pg8::EpiIn, pg8::StaticOrder>(lds + RING_OFF, lds + EPIX_OFF, g, S, E);
        if (BOTH(1)) GRID_BAR();
    }

    STAMP(2);
    if (IN(2)) {
        STAMPA(22); STAMPA(24);
        for (int it = gw; it < (MP / 16) * 4; it += NGW) {
            const int rb = it >> 2, gp = it & 3, w = 2 << gp, row0 = rb * 16, pos0 = row0 & (SEQ - 1), c = 256 * gp + 4 * lane;
            const float* up = U + (size_t)row0 * PW + c;
            f32x4 s = (f32x4){0.f, 0.f, 0.f, 0.f};
            { f32x4 pre[15];
#pragma unroll
              for (int j = 1; j < 16; ++j) { pre[j - 1] = (f32x4){0.f, 0.f, 0.f, 0.f}; if (j < w && pos0 - j >= 0) pre[j - 1] = *(const f32x4*)(up - (long)j * PW); }
#pragma unroll
              for (int j = 0; j < 15; ++j) s += pre[j]; }
#pragma unroll
            for (int ch = 0; ch < 2; ++ch) {
                f32x4 ut[8], uo[8];
#pragma unroll
                for (int i = 0; i < 8; ++i) { const int ii = ch * 8 + i; ut[i] = *(const f32x4*)(up + (long)ii * PW);
                    uo[i] = (f32x4){0.f, 0.f, 0.f, 0.f}; if (pos0 + ii - (w - 1) >= 0) uo[i] = *(const f32x4*)(up + (long)(ii - (w - 1)) * PW); }
#pragma unroll
                for (int i = 0; i < 8; ++i) { const int ii = ch * 8 + i, pos = pos0 + ii;
                    s += ut[i];
                    const float cnt = (float)(pos + 1 < w ? pos + 1 : w);
                    const f32x4 p = s / cnt - ut[i];
                    *(u32x2*)(Pb + (size_t)(row0 + ii) * PW + c) = (u32x2){cvtpk(p[0], p[1]), cvtpk(p[2], p[3])};
                    s -= uo[i];
                    if (pos >= SEQ - PSTATE) *(f32x4*)(out + OFF_PP + ((size_t)(row0 / SEQ) * PSTATE + (pos - (SEQ - PSTATE))) * PW + c) = ut[i]; }
            }
        }
        for (int it = gw; it < DB * 4; it += NGW) {
            const int b = it >> 2, gp = it & 3, w = 2 << gp, c = 256 * gp + 4 * lane;
            const float* st = state_pool + (size_t)b * PSTATE * PW + c; const float* un = U + (size_t)(MP + b * DS) * PW + c;
            for (int i = 0; i < DS; ++i) {
                f32x4 s = (f32x4){0.f, 0.f, 0.f, 0.f};
                for (int j = 0; j < w; ++j) { const int e = PSTATE + i - j; s += e >= PSTATE ? *(const f32x4*)(un + (size_t)(e - PSTATE) * PW) : *(const f32x4*)(st + (size_t)e * PW); }
                const f32x4 ut = *(const f32x4*)(un + (size_t)i * PW);
                const f32x4 p = s / (float)w - ut;
                *(u32x2*)(Pb + (size_t)(MP + b * DS + i) * PW + c) = (u32x2){cvtpk(p[0], p[1]), cvtpk(p[2], p[3])};
            }
            for (int j = 0; j < PSTATE; ++j) { const int e = DS + j;
                *(f32x4*)(out + OFF_PS + ((size_t)b * PSTATE + j) * PW + c) = e >= PSTATE ? *(const f32x4*)(un + (size_t)(e - PSTATE) * PW) : *(const f32x4*)(st + (size_t)e * PW); }
        }
        __syncthreads();
        STAMPB(22); STAMPA(20);
        for (int half = 0; half < 2; ++half) {
            if ((half == 0) == ((vcu & 1) == 0)) {
                for (int id = vcu; id < DB * DCH; id += G) att::decode_unit(id / DCH, id % DCH, Qb, cache_k, cache_v, page_table, sb_bias, DPO, DPW, lds + RING_OFF);
            } else {
                for (int pi = vcu; pi < NB * NH * 8; pi += G) { const int bh = pi >> 3, s = pi & 7;
                    att::prompt_unit(bh / NH, bh % NH, s, Qb, Kb, Vb, Ob, sb_bias, lds + RING_OFF);
                    att::prompt_unit(bh / NH, bh % NH, 15 - s, Qb, Kb, Vb, Ob, sb_bias, lds + RING_OFF); }
            }
            __syncthreads();
            if (half == 0) { STAMPB(20); STAMPA(21); } else { STAMPB(21); STAMPB(24); }
        }
        if (BOTH(2)) GRID_BAR();
    }

    STAMP(3);
    if (IN(3)) {
        for (int id = gw; id < DB * NH * DS; id += NGW) {
            const int b = id / (NH * DS), h = (id / DS) % NH, i = id % DS;
            const size_t r0 = (size_t)(MP + b * DS);
            const float qd = bflo((unsigned)Qb[(r0 + i) * AW + h * HD + lane]);
            const float bias2 = sb_bias[h] * LOG2E;
            float carry = 1.0f, o = 0.f;
            for (int j = i - 1; j >= 0; --j) {
                const float kd = bflo((unsigned)Kb[(r0 + j) * AW + h * HD + lane]), vd = bflo((unsigned)Vb[(r0 + j) * AW + h * HD + lane]);
                const float z2 = wave_sum(qd * kd) + bias2;
                const float e = __builtin_amdgcn_exp2f(z2), w = __builtin_amdgcn_rcpf(1.0f + e);
                carry *= w; o += e * carry * vd;
            }
            const float* op = DPO + (((size_t)b * NH + h) * DCH * DS + i) * HD + lane; const float* wp = DPW + ((size_t)b * NH + h) * DCH * DS + i;
            float oc[DCH], wc_[DCH];
#pragma unroll
            for (int c = 0; c < DCH; ++c) { oc[c] = op[(size_t)c * DS * HD]; wc_[c] = wp[c * DS]; }
#pragma unroll
            for (int c = DCH - 1; c >= 0; --c) { o += carry * oc[c]; carry *= wc_[c]; }
            Ob[(r0 + i) * AW + h * HD + lane] = (bf16_t)(cvtpk(o, 0.f) & 0xffffu);
        }
        if (BOTH(3)) GRID_BAR();
    }

    STAMP(4);
    if (IN(4)) {
        pg8::StaticOrder S; S.init(MP, DM, G, bx);
        { pg8::Gemm g{Pb, Wpool_t, PW, 256, 256, 1, 256}; pg8::EpiPool E{SGB, pool_scale, MIX};
          pg8::gemm_phase<pg8::EpiPool, pg8::StaticOrder>(lds + RING_OFF, lds + EPIX_OFF, g, S, E); }
        { pg8::Gemm g{Ob, Wap_t, AW, AW, AW, 0, 0}; pg8::EpiProj E{SGA, MIX};
          pg8::gemm_phase<pg8::EpiProj, pg8::StaticOrder>(lds + RING_OFF, lds + EPIX_OFF, g, S, E); }
        { sk::SkPool SE1{SGB, pool_scale, MIX}; sk::SkProj SE2{SGA, MIX};
          for (int j = G - 1 - bx; j < DM / 64; j += G) {
              { const bf16_t* Bp = Wpool_t + (size_t)(64 * j) * 256; sk::unit<2>(lds + RING_OFF, Pb + (size_t)MP * PW + (j >> 3) * 256, PW, Bp, Bp + (size_t)32 * 256, 256, 256, SE1, j); }
              __syncthreads();
              { const bf16_t* Bp = Wap_t + (size_t)(64 * j) * AW; sk::unit<8>(lds + RING_OFF, Ob + (size_t)MP * AW, AW, Bp, Bp + (size_t)32 * AW, AW, AW, SE2, j); }
              __syncthreads(); } }
        if (BOTH(4)) GRID_BAR();
    }

    STAMP(5);
    if (IN(5)) {
        pg8::Gemm g{MIX, Wout_t, DM, DM, DM, 0, 0}; pg8::StaticOrder S; S.init(MP, DM, G, bx);
        pg8::EpiOut E{x_p, HB, SS};
        pg8::gemm_phase<pg8::EpiOut, pg8::StaticOrder>(lds + RING_OFF, lds + EPIX_OFF, g, S, E);
        { sk::SkOut SE{x_s, HB, SS};
          for (int j = G - 1 - bx; j < DM / 64; j += G) { const bf16_t* Bp = Wout_t + (size_t)(64 * j) * DM;
              sk::unit<8>(lds + RING_OFF, MIX + (size_t)MP * DM, DM, Bp, Bp + (size_t)32 * DM, DM, DM, SE, j); __syncthreads(); } }
        if (BOTH(5)) GRID_BAR();
    }

    STAMP(6);
    if (IN(6)) {
        pg8::Gemm g{HB, Wgu_t, DM, DM, DM, 0, 0}; pg8::StaticOrder S; S.init(MP, 2 * DFF, G, bx);
        pg8::EpiGU E{SS, ACT};
        pg8::gemm_phase<pg8::EpiGU, pg8::StaticOrder>(lds + RING_OFF, lds + EPIX_OFF, g, S, E);
        { sk::SkGU SE{SS, ACT};
          for (int j = G - 1 - bx; j < DFF / 32; j += G) { const bf16_t* Bp = Wgu_t + (size_t)(256 * (j >> 2) + 32 * (j & 3)) * DM;
              sk::unit<8>(lds + RING_OFF, HB + (size_t)MP * DM, DM, Bp, Bp + (size_t)128 * DM, DM, DM, SE, j); __syncthreads(); } }
        if (BOTH(6)) GRID_BAR();
    }

    STAMP(7);
    if (IN(7)) {
        pg8::Gemm g{ACT, Wd_t, DFF, DFF, DFF, 0, 0}; pg8::StaticOrder S; S.init(MP, DM, G, bx);
        pg8::EpiDown E{HB, out};
        pg8::gemm_phase<pg8::EpiDown, pg8::StaticOrder>(lds + RING_OFF, lds + EPIX_OFF, g, S, E);
        { sk::SkDown SE{HB, out};
          for (int j = G - 1 - bx; j < DM / 64; j += G) { const bf16_t* Bp = Wd_t + (size_t)(64 * j) * DFF;
              sk::unit<11>(lds + RING_OFF, ACT + (size_t)MP * DFF, DFF, Bp, Bp + (size_t)32 * DFF, DFF, DFF, SE, j); __syncthreads(); } }
    }
    if (PROBE_X > 0) {
        GRID_BAR();
        STAMP(8);
        if (PROBE_X == 1) { pg8::Gemm g{XN, Win_t, DM, DM, DM, 0, 0}; pg8::StaticOrder S; S.init(MP, INC, G, bx); pg8::EpiNull E{DPW}; pg8::gemm_phase<pg8::EpiNull, pg8::StaticOrder>(lds + RING_OFF, lds + EPIX_OFF, g, S, E); }
        if (PROBE_X == 6) { pg8::Gemm g{HB, Wgu_t, DM, DM, DM, 0, 0}; pg8::StaticOrder S; S.init(MP, 2 * DFF, G, bx); pg8::EpiNull E{DPW}; pg8::gemm_phase<pg8::EpiNull, pg8::StaticOrder>(lds + RING_OFF, lds + EPIX_OFF, g, S, E); }
        if (PROBE_X == 7) { pg8::Gemm g{ACT, Wd_t, DFF, DFF, DFF, 0, 0}; pg8::StaticOrder S; S.init(MP, DM, G, bx); pg8::EpiNull E{DPW}; pg8::gemm_phase<pg8::EpiNull, pg8::StaticOrder>(lds + RING_OFF, lds + EPIX_OFF, g, S, E); }
        GRID_BAR();
        STAMP(9);
    }
    if (PROBE_T == 7 || PROBE_T == 100) GRID_BAR();
    if (PROBE_X == 0) STAMP(8);
    if (PROBE_T == 100 && bx == PROBE_BLK && tid == 0) tk1 = __builtin_amdgcn_s_memrealtime();
    if (PROBE_T >= 0 && bx == PROBE_BLK && tid == 0) { const unsigned long long d = (PROBE_T >= 20 && PROBE_T < 100) ? (unsigned long long)__hip_atomic_load(ctl + CW_PROBE, __ATOMIC_RELAXED, __HIP_MEMORY_SCOPE_AGENT) : tk1 - tk0, t0 = __builtin_amdgcn_s_memrealtime(); while (__builtin_amdgcn_s_memrealtime() - t0 < d) __builtin_amdgcn_s_sleep(8); }
#undef IN
#undef BOTH
#undef GRID_BAR
#undef STAMP
}

extern "C" void kernel_launch(void* const* d_in, const int* in_sizes, int n_in, void* d_out, int out_size, void* d_ws, size_t ws_size, hipStream_t stream) {
    static int grid = 0;
    if (grid == 0) {
        if (n_in != 18 || (size_t)out_size != OUT_TOTAL || ws_size < WS_END) { fprintf(stderr, "kernel_launch: unexpected sizes (n_in %d, out %d, ws %zu)\n", n_in, out_size, ws_size); grid = -1; return; }
        int dev = 0, cus = 0, per_cu = 0;
        if (hipGetDevice(&dev) != hipSuccess || hipDeviceGetAttribute(&cus, hipDeviceAttributeMultiprocessorCount, dev) != hipSuccess) { grid = -1; return; }
        if (hipFuncSetAttribute((const void*)fwd_kernel, hipFuncAttributeMaxDynamicSharedMemorySize, LDS_BYTES) != hipSuccess) { fprintf(stderr, "kernel_launch: hipFuncSetAttribute failed\n"); grid = -1; return; }
        if (hipOccupancyMaxActiveBlocksPerMultiprocessor(&per_cu, (const void*)fwd_kernel, NWAVES * 64, LDS_BYTES) != hipSuccess || per_cu < 1)
            fprintf(stderr, "kernel_launch: occupancy query reports %d workgroups per CU\n", per_cu);
        (void)hipGetLastError();
        grid = cus;
    }
    if (grid < 0) return;
    if (hipMemsetAsync((char*)d_ws + WS_CTL, 0, CTL_ZERO_BYTES, stream) != hipSuccess) return;
    Args a{};
    for (int i = 0; i < 18; ++i) a.in[i] = d_in[i];
    a.out = (float*)d_out; a.ws = (unsigned char*)d_ws;
    if (PROBE_PH >= 0) {
        a.ph_lo = 0; a.ph_hi = PROBE_PH + 1; a.li = 0; hipLaunchKernelGGL(fwd_kernel, dim3(grid), dim3(NWAVES * 64), LDS_BYTES, stream, a);
        a.ph_lo = PROBE_PH; a.ph_hi = N_PHASES; a.li = 1; hipLaunchKernelGGL(fwd_kernel, dim3(grid), dim3(NWAVES * 64), LDS_BYTES, stream, a);
    } else if (MK_N_LAUNCHES == N_PHASES) {
        for (int li = 0; li < N_PHASES; ++li) { a.ph_lo = li; a.ph_hi = li + 1; a.li = 0; hipLaunchKernelGGL(fwd_kernel, dim3(grid), dim3(NWAVES * 64), LDS_BYTES, stream, a); }
    } else {
        a.ph_lo = 0; a.ph_hi = N_PHASES; a.li = 0;
        hipLaunchKernelGGL(fwd_kernel, dim3(grid), dim3(NWAVES * 64), LDS_BYTES, stream, a);
    }
}
```
